# Optimizing an MI355X kernel written in HIP

```python
import math
import jax, jax.numpy as jnp
from jax import lax
import numpy as np

D_MODEL = 1024
BATCH = 4
SEQ = 4096
DEPTH = 1
DEC_BATCH = 8
DEC_SEQ = 32
PAST_LEN = 4096

CHUNK = 64
N_META = 16
N_DIFF_HEADS = 8
DIFF_HEAD_DIM = 64
DIFF_V_DIM = 2 * DIFF_HEAD_DIM
DIFF_WIDTH = N_DIFF_HEADS * DIFF_V_DIM
N_SB_HEADS = 8
SB_HEAD_DIM = 64
SB_WIDTH = N_SB_HEADS * SB_HEAD_DIM
N_BRANCH = 2
D_FF = 4 * D_MODEL
ROT_DIM = DIFF_HEAD_DIM // 4
ROPE_THETA = 500000.0
Q_BLOCK = 128
EPS = 1e-6
NEG_INF = -1e30
IN_COLS = 3 * DIFF_WIDTH + 3 * SB_WIDTH + N_BRANCH * D_MODEL
IN_SPLITS = [DIFF_WIDTH, 2 * DIFF_WIDTH, 3 * DIFF_WIDTH,
             3 * DIFF_WIDTH + SB_WIDTH, 3 * DIFF_WIDTH + 2 * SB_WIDTH, 3 * DIFF_WIDTH + 3 * SB_WIDTH]

kernel_name = "hybrid_diff_stickbreak_stream_step"


def _rmsnorm(x, g):
    x32 = x.astype(jnp.float32)
    y = x32 * lax.rsqrt(jnp.mean(x32 * x32, axis=-1, keepdims=True) + EPS)
    return (y * g.astype(jnp.float32)).astype(x.dtype)


def _rope(x, pos):
    half = ROT_DIM // 2
    inv = ROPE_THETA ** (-jnp.arange(0, ROT_DIM, 2, dtype=jnp.float32) / ROT_DIM)
    ang = pos.astype(jnp.float32)[:, None] * inv[None, :]
    shp = (pos.shape[0],) + (1,) * (x.ndim - 3) + (half,)
    cos = jnp.cos(ang).reshape(shp)
    sin = jnp.sin(ang).reshape(shp)
    xr = x[..., :ROT_DIM].astype(jnp.float32)
    x1, x2 = xr[..., :half], xr[..., half:]
    rot = jnp.concatenate([x1 * cos - x2 * sin, x2 * cos + x1 * sin], axis=-1)
    return jnp.concatenate([rot.astype(x.dtype), x[..., ROT_DIM:]], axis=-1)


def _query_blocks(tq):
    blk = min(Q_BLOCK, tq)
    return blk, -(-tq // blk)


def _split_blocks(a, blk, nb, axis):
    pad = nb * blk - a.shape[axis]
    widths = [(0, 0)] * a.ndim
    widths[axis] = (0, pad)
    a = jnp.pad(a, widths, mode="edge")
    a = a.reshape(a.shape[:axis] + (nb, blk) + a.shape[axis + 1:])
    return jnp.moveaxis(a, axis, 0)


def _merge_blocks(o, tq):
    o = jnp.moveaxis(o, 0, 1)
    o = o.reshape((o.shape[0], -1) + o.shape[3:])
    return o[:, :tq]


def _diff_attention(q, k, v, q_chunk, k_chunk, lam):
    tq = q.shape[1]
    blk, nb = _query_blocks(tq)
    scale = DIFF_HEAD_DIM ** -0.5

    def block(args):
        qb, cb = args
        s = jnp.einsum("bqhcd,bkhcd->bchqk", qb, k).astype(jnp.float32) * scale
        mask = k_chunk[None, :] <= cb[:, None]
        p = jax.nn.softmax(jnp.where(mask, s, NEG_INF), axis=-1)
        a = p[:, 0] - lam * p[:, 1]
        return jnp.einsum("bhqk,bkhe->bqhe", a.astype(v.dtype), v)

    o = lax.map(block, (_split_blocks(q, blk, nb, 1), _split_blocks(q_chunk, blk, nb, 0)))
    return _merge_blocks(o, tq)


def _stick_breaking(q, k, v, q_idx, k_idx):
    tq = q.shape[1]
    blk, nb = _query_blocks(tq)
    scale = SB_HEAD_DIM ** -0.5

    def block(args):
        qb, ib = args
        z = jnp.einsum("bqhd,bkhd->bhqk", qb, k).astype(jnp.float32) * scale
        mask = k_idx[None, :] < ib[:, None]
        log_1m = jnp.where(mask, jax.nn.log_sigmoid(-z), 0.0)
        suffix = lax.cumsum(log_1m, axis=3, reverse=True) - log_1m
        w = jnp.where(mask, jnp.exp(jax.nn.log_sigmoid(z) + suffix), 0.0)
        return jnp.einsum("bhqk,bkhd->bqhd", w.astype(v.dtype), v)

    o = lax.map(block, (_split_blocks(q, blk, nb, 1), _split_blocks(q_idx, blk, nb, 0)))
    return _merge_blocks(o, tq)


def _layer(x, q_pos, q_chunk, k_pos, k_chunk, past_dk, past_dv, past_sk, past_sv, lam_init,
           g_mix, w_in, q_norm_g, k_norm_g, lam_q1, lam_k1, lam_q2, lam_k2, sub_g,
           w_diff_out, w_sb_out, w_out, g_ffn, w_ff1, w_ff2):
    b, t, _ = x.shape
    h = _rmsnorm(x, g_mix)
    dq, dk, dv, sq, sk, sv, gate = jnp.split(h @ w_in, IN_SPLITS, axis=-1)
    dq = _rope(_rmsnorm(dq.reshape(b, t, N_DIFF_HEADS, 2, DIFF_HEAD_DIM), q_norm_g), q_pos)
    dk = _rope(_rmsnorm(dk.reshape(b, t, N_DIFF_HEADS, 2, DIFF_HEAD_DIM), k_norm_g), q_pos)
    dk = dk.reshape(b, t, N_DIFF_HEADS, 2 * DIFF_HEAD_DIM)
    dv = dv.reshape(b, t, N_DIFF_HEADS, DIFF_V_DIM)
    sq = sq.reshape(b, t, N_SB_HEADS, SB_HEAD_DIM)
    sk = sk.reshape(b, t, N_SB_HEADS, SB_HEAD_DIM)
    sv = sv.reshape(b, t, N_SB_HEADS, SB_HEAD_DIM)
    if past_dk is None:
        dk_all, dv_all, sk_all, sv_all = dk, dv, sk, sv
    else:
        dk_all = jnp.concatenate([past_dk, dk], axis=1)
        dv_all = jnp.concatenate([past_dv, dv], axis=1)
        sk_all = jnp.concatenate([past_sk, sk], axis=1)
        sv_all = jnp.concatenate([past_sv, sv], axis=1)
    f32 = jnp.float32
    lam = (jnp.exp(jnp.sum(lam_q1.astype(f32) * lam_k1.astype(f32)))
           - jnp.exp(jnp.sum(lam_q2.astype(f32) * lam_k2.astype(f32))) + lam_init)
    o_d = _diff_attention(dq, dk_all.reshape(b, -1, N_DIFF_HEADS, 2, DIFF_HEAD_DIM), dv_all,
                          q_chunk, k_chunk, lam)
    o_d = _rmsnorm(o_d, sub_g) * (1.0 - lam_init)
    o_s = _stick_breaking(sq, sk_all, sv_all, q_pos, k_pos)
    g_d, g_s = jnp.split(jax.nn.sigmoid(gate), N_BRANCH, axis=-1)
    merged = (g_d * (o_d.reshape(b, t, DIFF_WIDTH) @ w_diff_out)
              + g_s * (o_s.reshape(b, t, SB_WIDTH) @ w_sb_out))
    x = x + merged @ w_out
    x = x + jnp.square(jax.nn.relu(_rmsnorm(x, g_ffn) @ w_ff1)) @ w_ff2
    return x, dk, dv, sk, sv


def setup_inputs(seed: int = 0) -> dict:
    key = jax.random.key(seed)
    ks = jax.random.split(key, 24)

    def n(k, shape, s):
        return jax.random.normal(k, shape, jnp.float32) * s

    return {
        "x_prompt": n(ks[0], (BATCH, SEQ, D_MODEL), 1.0),
        "x_sample": n(ks[1], (DEC_BATCH, DEC_SEQ, D_MODEL), 1.0),
        "cache_diff_k": n(ks[2], (DEPTH, DEC_BATCH, PAST_LEN, N_DIFF_HEADS, 2 * DIFF_HEAD_DIM), 1.0),
        "cache_diff_v": n(ks[3], (DEPTH, DEC_BATCH, PAST_LEN, N_DIFF_HEADS, DIFF_V_DIM), 1.0),
        "cache_sb_k": n(ks[4], (DEPTH, DEC_BATCH, PAST_LEN, N_SB_HEADS, SB_HEAD_DIM), 1.0),
        "cache_sb_v": n(ks[5], (DEPTH, DEC_BATCH, PAST_LEN, N_SB_HEADS, SB_HEAD_DIM), 1.0),
        "meta_tokens": n(ks[6], (N_META, D_MODEL), 1.0),
        "g_mix": 1.0 + n(ks[7], (DEPTH, D_MODEL), 0.02),
        "w_in": n(ks[8], (DEPTH, D_MODEL, IN_COLS), D_MODEL ** -0.5),
        "q_norm_g": 1.0 + n(ks[9], (DEPTH, DIFF_HEAD_DIM), 0.02),
        "k_norm_g": 1.0 + n(ks[10], (DEPTH, DIFF_HEAD_DIM), 0.02),
        "lam_q1": n(ks[11], (DEPTH, DIFF_HEAD_DIM), 0.1),
        "lam_k1": n(ks[12], (DEPTH, DIFF_HEAD_DIM), 0.1),
        "lam_q2": n(ks[13], (DEPTH, DIFF_HEAD_DIM), 0.1),
        "lam_k2": n(ks[14], (DEPTH, DIFF_HEAD_DIM), 0.1),
        "sub_g": 1.0 + n(ks[15], (DEPTH, DIFF_V_DIM), 0.02),
        "w_diff_out": n(ks[16], (DEPTH, DIFF_WIDTH, D_MODEL), DIFF_WIDTH ** -0.5),
        "w_sb_out": n(ks[17], (DEPTH, SB_WIDTH, D_MODEL), SB_WIDTH ** -0.5),
        "w_out": n(ks[18], (DEPTH, D_MODEL, D_MODEL), D_MODEL ** -0.5),
        "g_ffn": 1.0 + n(ks[19], (DEPTH, D_MODEL), 0.02),
        "w_ff1": n(ks[20], (DEPTH, D_MODEL, D_FF), D_MODEL ** -0.5),
        "w_ff2": n(ks[21], (DEPTH, D_FF, D_MODEL), D_FF ** -0.5),
    }


def reference(x_prompt, x_sample, cache_diff_k, cache_diff_v, cache_sb_k, cache_sb_v, meta_tokens,
              g_mix, w_in, q_norm_g, k_norm_g, lam_q1, lam_k1, lam_q2, lam_k2, sub_g,
              w_diff_out, w_sb_out, w_out, g_ffn, w_ff1, w_ff2):
    b, s, _ = x_prompt.shape
    t = s + N_META
    meta = jnp.broadcast_to(meta_tokens[None].astype(x_prompt.dtype), (b, N_META, D_MODEL))
    xp = jnp.concatenate([meta, x_prompt], axis=1)
    p_pos = jnp.arange(t, dtype=jnp.int32)
    p_chunk = jnp.where(p_pos < N_META, 0, (p_pos - N_META) // CHUNK + 1)
    past_len = cache_diff_k.shape[2]
    ds = x_sample.shape[1]
    k_pos_s = jnp.arange(past_len + ds, dtype=jnp.int32)
    k_chunk_s = k_pos_s // CHUNK + 1
    q_pos_s = k_pos_s[past_len:]
    q_chunk_s = k_chunk_s[past_len:]
    xs = x_sample
    pdk, pdv, psk, psv, sdk, sdv, ssk, ssv = [], [], [], [], [], [], [], []
    for l in range(DEPTH):
        lam_init = 0.8 - 0.6 * math.exp(-0.3 * l)
        xp, a1, a2, a3, a4 = _layer(
            xp, p_pos, p_chunk, p_pos, p_chunk, None, None, None, None, lam_init,
            g_mix[l], w_in[l], q_norm_g[l], k_norm_g[l], lam_q1[l], lam_k1[l], lam_q2[l], lam_k2[l],
            sub_g[l], w_diff_out[l], w_sb_out[l], w_out[l], g_ffn[l], w_ff1[l], w_ff2[l])
        xs, c1, c2, c3, c4 = _layer(
            xs, q_pos_s, q_chunk_s, k_pos_s, k_chunk_s,
            cache_diff_k[l], cache_diff_v[l], cache_sb_k[l], cache_sb_v[l], lam_init,
            g_mix[l], w_in[l], q_norm_g[l], k_norm_g[l], lam_q1[l], lam_k1[l], lam_q2[l], lam_k2[l],
            sub_g[l], w_diff_out[l], w_sb_out[l], w_out[l], g_ffn[l], w_ff1[l], w_ff2[l])
        pdk.append(a1); pdv.append(a2); psk.append(a3); psv.append(a4)
        sdk.append(c1); sdv.append(c2); ssk.append(c3); ssv.append(c4)
    y_prompt = xp[:, N_META:]
    y_sample = xs
    return (y_prompt, y_sample,
            jnp.stack(pdk), jnp.stack(pdv), jnp.stack(psk), jnp.stack(psv),
            jnp.stack(sdk), jnp.stack(sdv), jnp.stack(ssk), jnp.stack(ssv))
```

```cpp
#include <hip/hip_runtime.h>
#include <hip/hip_cooperative_groups.h>
#include <cstdio>
#include <cstdint>
namespace cg = cooperative_groups;
__device__ __forceinline__ int opaque_tid() { int t = threadIdx.x; asm volatile("" : "+v"(t)); return t; }
namespace pg8 {
#define PG8_LAS __attribute__((address_space(3)))
typedef unsigned short bf16_t;
typedef short bf16x8 __attribute__((ext_vector_type(8)));
typedef float f32x4 __attribute__((ext_vector_type(4)));
typedef unsigned u32x4 __attribute__((ext_vector_type(4)));
constexpr int BM = 256, BK = 64, HALF = 128, HTB = HALF * BK * 2  , STAGE_BYTES = 8 * HTB, NXCD = 8, WGM = 8;

__host__ __device__ __forceinline__ int lds_byte(int r, int c) { const int st = (r >> 4) * 2 + (c >> 5), rr = r & 15, cc = c & 31, ob = rr * 64 + cc * 2; return st * 1024 + (ob ^ (((ob >> 9) & 1) << 5)); }
__host__ __device__ __forceinline__ void stage_rc(int b, int& R, int& C) { const int st = b / 1024, sb = b % 1024, swz = sb ^ (((sb >> 9) & 1) << 5); R = (st >> 1) * 16 + swz / 64; C = (st & 1) * 32 + (swz % 64) / 2; }
__host__ __device__ __forceinline__ int perm32(int rho) { const int n = rho >> 4, i = rho & 15; return 8 * (i >> 2) + 4 * n + (i & 3); }

struct Unit { int pm, pn; };
struct Gemm { const bf16_t* A; const bf16_t* Bt; int M, N, K; };

struct StaticOrder {
    int nM, nN, nwg, G, c;
    __host__ __device__ void init(int M, int N, int G_, int c_) { nM = M / BM; nN = N / BM; nwg = nM * nN; G = G_; c = c_; }
    __host__ __device__ bool next(int i, Unit& u) const {
        const long L = (long)i * G + c; if (L >= nwg) return false;
        int wgid = (int)L; { const int q = nwg / NXCD, r = nwg % NXCD, xcd = wgid % NXCD, off = wgid / NXCD; wgid = (xcd < r ? xcd * (q + 1) : r * (q + 1) + (xcd - r) * q) + off; }
        const int nig = WGM * nN, gid = wgid / nig, fm = gid * WGM, gsz = (nM - fm) < WGM ? (nM - fm) : WGM;
        u.pm = fm + ((wgid % nig) % gsz); u.pn = (wgid % nig) / gsz; return true;
    }
    __device__ __forceinline__ void a_ready(const Unit&) const {}
    __device__ __forceinline__ void done(const Unit&) const {}
};

__device__ __forceinline__ unsigned cvt_pk_bf16(float lo, float hi) { unsigned r; asm volatile("v_cvt_pk_bf16_f32 %0, %1, %2" : "=v"(r) : "v"(lo), "v"(hi)); return r; }
typedef float f32x2 __attribute__((ext_vector_type(2)));
template <class Epi, class Sched, bool ALIGN_EPI = false, bool SP2 = false>
__device__ __forceinline__ void gemm_phase(PG8_LAS unsigned char* lds, const Gemm g, const Sched& S, const Epi& E) {
    const int tid = opaque_tid(), wid = __builtin_amdgcn_readfirstlane(tid >> 6), lane = tid & 63, wr = wid >> 2, wc = wid & 3, fr = lane & 15, fq = lane >> 4;
    const int K = g.K, nt = K / BK;
    unsigned voffA[2], voffB[2];
#pragma unroll
    for (int i = 0; i < 2; ++i) { int R, C; stage_rc(tid * 16 + i * 8192, R, C); const int Rb = Epi::PERM ? ((R & ~31) + perm32(R & 31)) : R;
        voffA[i] = (unsigned)(R * K + C) * 2u; voffB[i] = (unsigned)(Rb * K + C) * 2u; }
    const size_t kstep = (size_t)(BK * 2);
    const size_t hstep = (size_t)HALF * K * 2;
    const size_t tstep = 2 * hstep;
    const unsigned ldsw = (unsigned)wid * 1024u;
    const int aoff = lds_byte(wr * 64 + fr, fq * 8), boff = lds_byte(wc * 32 + fr, fq * 8);
#define PG8_SA(b, h) (((b) * 2 + (h)) * HTB)
#define PG8_SB(b, h) ((4 + (b) * 2 + (h)) * HTB)
#define PG8_STAGE(bufoff, gbase, voff) do { _Pragma("unroll") for (int _i = 0; _i < 2; ++_i) \
        __builtin_amdgcn_global_load_lds((const unsigned*)((const char*)(gbase) + (voff)[_i]), (PG8_LAS unsigned*)(lds + (bufoff) + ldsw + _i * 8192), 16, 0, 0); } while (0)
#define PG8_LDA(dst, b, h) do { _Pragma("unroll") for (int m = 0; m < 4; ++m) _Pragma("unroll") for (int k = 0; k < 2; ++k) dst[m][k] = *(const PG8_LAS bf16x8*)(lds + PG8_SA(b, h) + aoff + m * 2048 + k * 1024); } while (0)
#define PG8_LDB(dst, b, h) do { _Pragma("unroll") for (int n = 0; n < 2; ++n) _Pragma("unroll") for (int k = 0; k < 2; ++k) dst[n][k] = *(const PG8_LAS bf16x8*)(lds + PG8_SB(b, h) + boff + n * 2048 + k * 1024); } while (0)
#define PG8_MMA(ai, bj, At, Bt) do { __builtin_amdgcn_s_setprio(1); _Pragma("unroll") for (int m = 0; m < 4; ++m) _Pragma("unroll") for (int n = 0; n < 2; ++n) _Pragma("unroll") for (int k = 0; k < 2; ++k) \
        acc[ai][bj][m][n] = __builtin_amdgcn_mfma_f32_16x16x32_bf16(Bt[n][k], At[m][k], acc[ai][bj][m][n], 0, 0, 0); __builtin_amdgcn_s_setprio(0); } while (0)
#define PG8_WAIT_V(n) asm volatile("s_waitcnt vmcnt(" #n ")" ::: "memory")
#define PG8_WAIT_L(n) asm volatile("s_waitcnt lgkmcnt(" #n ")" ::: "memory")
#define PG8_BAR __builtin_amdgcn_s_barrier()
#define PG8_SCHED __builtin_amdgcn_sched_barrier(0)
    Unit cur, nxt; int ui = 0;
    if (!S.next(0, cur)) return;
    f32x4 acc[2][2][4][2];
#pragma unroll
    for (int a = 0; a < 2; ++a)
#pragma unroll
        for (int b = 0; b < 2; ++b)
#pragma unroll
            for (int m = 0; m < 4; ++m)
#pragma unroll
                for (int n = 0; n < 2; ++n) acc[a][b][m][n] = (f32x4){0.f, 0.f, 0.f, 0.f};
    bf16x8 At[4][2], B0[2][2], B1[2][2];
    const char* cA = (const char*)g.A + (size_t)cur.pm * tstep; const char* cB = (const char*)g.Bt + (size_t)cur.pn * tstep;
    S.a_ready(cur);
    if constexpr (SP2) {
        PG8_STAGE(PG8_SB(0, 0), cB, voffB); PG8_STAGE(PG8_SB(0, 1), cB + hstep, voffB); PG8_STAGE(PG8_SA(0, 0), cA, voffA); PG8_STAGE(PG8_SA(0, 1), cA + hstep, voffA);
        if (wr == 1) PG8_BAR;
        PG8_WAIT_V(2); PG8_BAR;
        PG8_STAGE(PG8_SB(1, 0), cB + kstep, voffB); PG8_STAGE(PG8_SA(1, 0), cA + kstep, voffA); PG8_STAGE(PG8_SB(1, 1), cB + hstep + kstep, voffB);
        PG8_WAIT_V(6); PG8_BAR;
    } else {
        PG8_STAGE(PG8_SB(0, 0), cB, voffB); PG8_STAGE(PG8_SA(0, 0), cA, voffA); PG8_STAGE(PG8_SB(0, 1), cB + hstep, voffB); PG8_STAGE(PG8_SA(0, 1), cA + hstep, voffA);
        if (wr == 1) PG8_BAR;
        PG8_WAIT_V(4); PG8_BAR;
        PG8_STAGE(PG8_SB(1, 0), cB + kstep, voffB); PG8_STAGE(PG8_SA(1, 0), cA + kstep, voffA); PG8_STAGE(PG8_SB(1, 1), cB + hstep + kstep, voffB);
        PG8_WAIT_V(6); PG8_BAR;
    }
    for (;;) {
        const bool has_next = S.next(ui + 1, nxt);
        const char* nA = has_next ? (const char*)g.A + (size_t)nxt.pm * tstep : cA; const char* nB = has_next ? (const char*)g.Bt + (size_t)nxt.pn * tstep : cB;
        for (int t = 0; t < nt; t += 2) {
            const bool last = (t == nt - 2);
            const char* a1 = cA + (size_t)(t + 1) * kstep;
            const char* a2 = last ? nA : cA + (size_t)(t + 2) * kstep; const char* b2 = last ? nB : cB + (size_t)(t + 2) * kstep;
            const char* a3 = a2 + kstep; const char* b3 = b2 + kstep;
            if (last && has_next) S.a_ready(nxt);
            if constexpr (SP2) {
            PG8_LDB(B0, 0, 0); PG8_LDB(B1, 0, 1); PG8_SCHED; PG8_LDA(At, 0, 0); PG8_STAGE(PG8_SA(1, 1), a1 + hstep, voffA);
            PG8_WAIT_V(8); PG8_WAIT_L(0); PG8_BAR; PG8_MMA(0, 0, At, B0); PG8_MMA(0, 1, At, B1); PG8_BAR; PG8_SCHED;
            PG8_LDA(At, 0, 1); PG8_STAGE(PG8_SB(0, 0), b2, voffB); PG8_STAGE(PG8_SB(0, 1), b2 + hstep, voffB); PG8_STAGE(PG8_SA(0, 0), a2, voffA);
            PG8_WAIT_V(8); PG8_WAIT_L(0); PG8_BAR; PG8_MMA(1, 0, At, B0); PG8_MMA(1, 1, At, B1); PG8_BAR; PG8_SCHED;
            PG8_LDB(B0, 1, 0); PG8_LDB(B1, 1, 1); PG8_SCHED; PG8_LDA(At, 1, 0); PG8_STAGE(PG8_SA(0, 1), a2 + hstep, voffA);
            PG8_WAIT_V(8); PG8_WAIT_L(0); PG8_BAR; PG8_MMA(0, 0, At, B0); PG8_MMA(0, 1, At, B1); PG8_BAR; PG8_SCHED;
            PG8_LDA(At, 1, 1); PG8_STAGE(PG8_SB(1, 0), b3, voffB); PG8_STAGE(PG8_SB(1, 1), b3 + hstep, voffB); PG8_STAGE(PG8_SA(1, 0), a3, voffA);
            PG8_WAIT_V(8); PG8_WAIT_L(0); PG8_BAR; PG8_MMA(1, 0, At, B0); PG8_MMA(1, 1, At, B1); PG8_BAR; PG8_SCHED;
            } else {
            PG8_LDB(B0, 0, 0); PG8_SCHED; PG8_LDA(At, 0, 0); PG8_STAGE(PG8_SA(1, 1), a1 + hstep, voffA);
            PG8_WAIT_L(8); PG8_BAR; PG8_WAIT_L(0); PG8_MMA(0, 0, At, B0); PG8_BAR; PG8_SCHED;
            PG8_LDB(B1, 0, 1); PG8_STAGE(PG8_SB(0, 0), b2, voffB);
            PG8_BAR; PG8_WAIT_L(0); PG8_MMA(0, 1, At, B1); PG8_BAR;
            PG8_LDA(At, 0, 1); PG8_STAGE(PG8_SA(0, 0), a2, voffA);
            PG8_BAR; PG8_WAIT_L(0); PG8_MMA(1, 0, At, B0); PG8_BAR; PG8_SCHED;
            PG8_STAGE(PG8_SB(0, 1), b2 + hstep, voffB);
            PG8_WAIT_V(6); PG8_BAR; PG8_MMA(1, 1, At, B1); PG8_BAR;
            PG8_LDB(B0, 1, 0); PG8_SCHED; PG8_LDA(At, 1, 0); PG8_STAGE(PG8_SA(0, 1), a2 + hstep, voffA);
            PG8_WAIT_L(8); PG8_BAR; PG8_WAIT_L(0); PG8_MMA(0, 0, At, B0); PG8_BAR; PG8_SCHED;
            PG8_LDB(B1, 1, 1); PG8_STAGE(PG8_SB(1, 0), b3, voffB);
            PG8_BAR; PG8_WAIT_L(0); PG8_MMA(0, 1, At, B1); PG8_BAR;
            PG8_LDA(At, 1, 1); PG8_STAGE(PG8_SA(1, 0), a3, voffA);
            PG8_BAR; PG8_WAIT_L(0); PG8_MMA(1, 0, At, B0); PG8_BAR; PG8_SCHED;
            PG8_STAGE(PG8_SB(1, 1), b3 + hstep, voffB);
            PG8_WAIT_V(6); PG8_BAR; PG8_MMA(1, 1, At, B1); PG8_BAR;
            }
        }
        if constexpr (ALIGN_EPI) { if (wr == 0) PG8_BAR; }
        if constexpr (!Epi::AFTER_DRAIN) { E(acc, cur, wr, wc, fr, fq); S.done(cur); }
        if (!has_next) break;
#pragma unroll
        for (int a = 0; a < 2; ++a)
#pragma unroll
            for (int b = 0; b < 2; ++b)
#pragma unroll
                for (int m = 0; m < 4; ++m)
#pragma unroll
                    for (int n = 0; n < 2; ++n) acc[a][b][m][n] = (f32x4){0.f, 0.f, 0.f, 0.f};
        cur = nxt; cA = nA; cB = nB; ++ui;
        if constexpr (ALIGN_EPI) { if (wr == 1) PG8_BAR; }
    }
    PG8_WAIT_V(0);
    if constexpr (!ALIGN_EPI) { if (wr == 0) PG8_BAR; }
    PG8_BAR;
    if constexpr (Epi::AFTER_DRAIN) { E.fused(acc, cur, wr, wc, fr, fq, lds, wid, lane); S.done(cur); }
#undef PG8_SA
#undef PG8_SB
#undef PG8_STAGE
#undef PG8_LDA
#undef PG8_LDB
#undef PG8_MMA
#undef PG8_WAIT_V
#undef PG8_WAIT_L
#undef PG8_BAR
#undef PG8_SCHED
}
}

#define LAS __attribute__((address_space(3)))
typedef unsigned short bf16_t;
typedef short bf16x8 __attribute__((ext_vector_type(8)));
typedef float f32x4 __attribute__((ext_vector_type(4)));
typedef float f32x16 __attribute__((ext_vector_type(16)));
typedef unsigned u32x4 __attribute__((ext_vector_type(4)));
typedef unsigned u32x2 __attribute__((ext_vector_type(2)));
typedef float f32x2_t __attribute__((ext_vector_type(2)));
typedef __bf16 bf16x2_t __attribute__((ext_vector_type(2)));

constexpr int DM = 1024, NBATCH = 4, SEQ = 4096, NMETA = 16, TP = SEQ + NMETA;
constexpr int DB = 8, DS = 32, PAST = 4096;
constexpr int RP = NBATCH * TP;
constexpr int RS = DB * DS;
constexpr int R1 = RP + RS;
constexpr int M1 = 16896;
constexpr int RC = NBATCH * SEQ;
constexpr int M2 = RC + RS;
constexpr int NIN = 6656, DFF = 4096;
constexpr float EPS = 1e-6f;
constexpr float QSCALE = 0.18033688011112042f;
constexpr float LAM_INIT = 0.2f;

constexpr size_t O_Y = 0, O_YS = 16777216, O_PDK = 17039360, O_PDV = 33882112, O_PSK = 50724864, O_PSV = 59146240,
                 O_SDK = 67567616, O_SDV = 67829760, O_SSK = 68091904, O_SSV = 68222976;

constexpr size_t MiB = 1u << 20;
constexpr size_t WS_WIN = 0, WS_WDO = 14 * MiB, WS_WSO = 16 * MiB, WS_WOUT = 17 * MiB, WS_W1 = 19 * MiB, WS_W2 = 27 * MiB;
constexpr size_t WS_ROPE = 35 * MiB, WS_SS = 36 * MiB, WS_BAR = 36 * MiB + 1536 * 1024, WS_PART = 38 * MiB;
constexpr size_t WS_XN = 50 * MiB;
constexpr size_t WS_QD = 83 * MiB, WS_KD = 116 * MiB, WS_VD = 149 * MiB;
constexpr size_t WS_QS = 182 * MiB, WS_KS = 199 * MiB, WS_VS = 216 * MiB;
constexpr size_t WS_T1 = 83 * MiB;
constexpr size_t WS_H = 83 * MiB;
constexpr size_t WS_G = 233 * MiB;
constexpr size_t WS_OD = 298 * MiB;
constexpr size_t WS_OS = 331 * MiB;
constexpr size_t WS_END = 348 * MiB;
constexpr int PART_FLOATS = 10400;

constexpr int LDS_BYTES = 147456;
#ifndef REP_P0
#define REP_P0 1
#endif
#ifndef REP_P1
#define REP_P1 1
#endif
#ifndef REP_P4
#define REP_P4 1
#endif
#ifndef REP_P5
#define REP_P5 1
#endif
#ifndef REP_P6
#define REP_P6 1
#endif
#ifndef REP_SYNC
#define REP_SYNC 0
#endif
#ifndef REP_DIFF
#define REP_DIFF 1
#endif
#ifndef REP_SB
#define REP_SB 1
#endif
#ifndef REP_P3
#define REP_P3 1
#endif
#ifndef REP_P2A
#define REP_P2A 1
#endif
#ifndef REP_P2B
#define REP_P2B 1
#endif

__device__ __forceinline__ unsigned cvtpk(float lo, float hi) { f32x2_t v = {lo, hi}; bf16x2_t b = __builtin_convertvector(v, bf16x2_t); return __builtin_bit_cast(unsigned, b); }
__device__ __forceinline__ float bf_lo(unsigned u) { return __uint_as_float(u << 16); }
__device__ __forceinline__ float bf_hi(unsigned u) { return __uint_as_float(u & 0xffff0000u); }
__device__ __forceinline__ int crow(int r, int hi) { return (r & 3) + 8 * (r >> 2) + 4 * hi; }
__device__ __forceinline__ float ex2(float x) { return __builtin_amdgcn_exp2f(x); }
__device__ __forceinline__ float lg2(float x) { return __builtin_amdgcn_logf(x); }
__device__ __forceinline__ float wave_sum(float v) {
#pragma unroll
    for (int o = 1; o < 64; o <<= 1) v += __shfl_xor(v, o);
    return v;
}
__device__ __forceinline__ u32x4 pack8(const float* v) { u32x4 w; w.x = cvtpk(v[0], v[1]); w.y = cvtpk(v[2], v[3]); w.z = cvtpk(v[4], v[5]); w.w = cvtpk(v[6], v[7]); return w; }

struct Args { const float* in[22]; float* out; unsigned char* ws; };
typedef const __attribute__((address_space(4))) Args* KArgs;
enum { I_XP = 0, I_XS, I_CDK, I_CDV, I_CSK, I_CSV, I_META, I_GMIX, I_WIN, I_QG, I_KG, I_LQ1, I_LK1, I_LQ2, I_LK2, I_SUBG, I_WDO, I_WSO, I_WOUT, I_GFFN, I_W1, I_W2 };

struct EpiIn {
    static constexpr bool PERM = true, AFTER_DRAIN = false;
    float* out; unsigned char* ws; const float* qg; const float* kg;
    __device__ __forceinline__ void operator()(const f32x4 (&acc)[2][2][4][2], const pg8::Unit& u, int wr, int wc, int fr, int fq) const {
        const int pn = u.pn;
        int type, cb;
        if (pn < 4) { type = 0; cb = 0; } else if (pn < 8) { type = 1; cb = 1024; } else if (pn < 12) { type = 2; cb = 2048; }
        else if (pn < 14) { type = 3; cb = 3072; } else if (pn < 16) { type = 4; cb = 3584; } else if (pn < 18) { type = 5; cb = 4096; } else { type = 6; cb = 4608; }
        const int col0 = pn * 256 + wc * 64 + fq * 8 - cb;
        const float* rope = (const float*)(ws + WS_ROPE);
        float gv[2][8];
        if (type <= 1) { const float* g = (type == 0) ? qg : kg;
#pragma unroll
            for (int bj = 0; bj < 2; ++bj)
#pragma unroll
                for (int i = 0; i < 8; ++i) gv[bj][i] = g[32 * bj + 8 * fq + i]; }
        bf16_t* bdst; int bld; size_t op, os; int ow;
        switch (type) {
            case 0: bdst = (bf16_t*)(ws + WS_QD); bld = 1024; op = 0; os = 0; ow = 0; break;
            case 1: bdst = (bf16_t*)(ws + WS_KD); bld = 1024; op = O_PDK; os = O_SDK; ow = 1024; break;
            case 2: bdst = (bf16_t*)(ws + WS_VD); bld = 1024; op = O_PDV; os = O_SDV; ow = 1024; break;
            case 3: bdst = (bf16_t*)(ws + WS_QS); bld = 512; op = 0; os = 0; ow = 0; break;
            case 4: bdst = (bf16_t*)(ws + WS_KS); bld = 512; op = O_PSK; os = O_SSK; ow = 512; break;
            case 5: bdst = (bf16_t*)(ws + WS_VS); bld = 512; op = O_PSV; os = O_SSV; ow = 512; break;
            default: bdst = (bf16_t*)(ws + WS_G); bld = 2048; op = 0; os = 0; ow = 0; break;
        }
#pragma unroll
        for (int ai = 0; ai < 2; ++ai)
#pragma unroll
            for (int m = 0; m < 4; ++m) {
                const int row = u.pm * 256 + ai * 128 + wr * 64 + m * 16 + fr;
                const bool valid = row < R1;
                const bool samp = row >= RP;
                int pos, crw;
                if (!samp) { const int b = row / TP; const int t = row - b * TP; pos = t; crw = (t >= NMETA) ? b * SEQ + t - NMETA : -1; }
                else { const int r = row - RP; pos = valid ? PAST + (r & 31) : 0; crw = RC + r; }
                float v[2][8];
#pragma unroll
                for (int bj = 0; bj < 2; ++bj)
#pragma unroll
                    for (int n = 0; n < 2; ++n)
#pragma unroll
                        for (int e = 0; e < 4; ++e) v[bj][4 * n + e] = acc[ai][bj][m][n][e];
                if (type <= 1) {
                    float ss = 0.f;
#pragma unroll
                    for (int bj = 0; bj < 2; ++bj)
#pragma unroll
                        for (int i = 0; i < 8; ++i) ss += v[bj][i] * v[bj][i];
                    ss += __shfl_xor(ss, 16); ss += __shfl_xor(ss, 32);
                    const float rstd = rsqrtf(ss * (1.0f / 64.0f) + EPS);
#pragma unroll
                    for (int bj = 0; bj < 2; ++bj)
#pragma unroll
                        for (int i = 0; i < 8; ++i) v[bj][i] *= rstd * gv[bj][i];
                    float pv[8];
#pragma unroll
                    for (int i = 0; i < 8; ++i) pv[i] = __shfl_xor(v[0][i], 16);
                    if (fq < 2) { const float* rp = rope + pos * 16;
#pragma unroll
                        for (int i = 0; i < 8; ++i) { const float c = rp[i], s = rp[8 + i]; v[0][i] = (fq == 0) ? (v[0][i] * c - pv[i] * s) : (v[0][i] * c + pv[i] * s); } }
                }
                if (type == 0 || type == 3) {
#pragma unroll
                    for (int bj = 0; bj < 2; ++bj)
#pragma unroll
                        for (int i = 0; i < 8; ++i) v[bj][i] *= QSCALE;
                }
                if (type == 6) {
#pragma unroll
                    for (int bj = 0; bj < 2; ++bj)
#pragma unroll
                        for (int i = 0; i < 8; ++i) v[bj][i] = __builtin_amdgcn_rcpf(1.0f + __expf(-v[bj][i]));
                }
                const int brow = (type == 6) ? crw : row;
                if (valid && brow >= 0) {
#pragma unroll
                    for (int bj = 0; bj < 2; ++bj) {
                        const int c = col0 + 32 * bj;
                        *(u32x4*)(bdst + (size_t)brow * bld + c) = pack8(v[bj]);
                        if (ow) { float* o = samp ? out + os + (size_t)(row - RP) * ow + c : out + op + (size_t)row * ow + c;
                            __builtin_nontemporal_store((f32x4){v[bj][0], v[bj][1], v[bj][2], v[bj][3]}, (f32x4*)o); __builtin_nontemporal_store((f32x4){v[bj][4], v[bj][5], v[bj][6], v[bj][7]}, (f32x4*)(o + 4)); }
                    }
                }
            }
    }
};

struct EpiGateA {
    static constexpr bool PERM = true, AFTER_DRAIN = false;
    const bf16_t* G; float* T1;
    __device__ __forceinline__ void operator()(const f32x4 (&acc)[2][2][4][2], const pg8::Unit& u, int wr, int wc, int fr, int fq) const {
        const int row0 = u.pm * 256 + wr * 64 + fr, c0 = u.pn * 256 + wc * 64 + fq * 8;
        u32x4 g[2][4][2];
#pragma unroll
        for (int ai = 0; ai < 2; ++ai)
#pragma unroll
            for (int m = 0; m < 4; ++m)
#pragma unroll
                for (int bj = 0; bj < 2; ++bj) g[ai][m][bj] = __builtin_nontemporal_load((const u32x4*)(G + (size_t)(row0 + ai * 128 + m * 16) * 2048 + c0 + bj * 32));
#pragma unroll
        for (int ai = 0; ai < 2; ++ai)
#pragma unroll
            for (int m = 0; m < 4; ++m)
#pragma unroll
                for (int bj = 0; bj < 2; ++bj) { const u32x4 gg = g[ai][m][bj];
                    const f32x4 a0 = acc[ai][bj][m][0], a1 = acc[ai][bj][m][1];
                    bf16_t* t = (bf16_t*)T1 + (size_t)(row0 + ai * 128 + m * 16) * 1024 + c0 + bj * 32;
                    float v[8] = {bf_lo(gg.x) * a0[0], bf_hi(gg.x) * a0[1], bf_lo(gg.y) * a0[2], bf_hi(gg.y) * a0[3], bf_lo(gg.z) * a1[0], bf_hi(gg.z) * a1[1], bf_lo(gg.w) * a1[2], bf_hi(gg.w) * a1[3]};
                    *(u32x4*)t = pack8(v); }
    }
};
struct EpiGateB {
    static constexpr bool PERM = true, AFTER_DRAIN = false;
    const bf16_t* G; const float* T1; bf16_t* MG;
    __device__ __forceinline__ void operator()(const f32x4 (&acc)[2][2][4][2], const pg8::Unit& u, int wr, int wc, int fr, int fq) const {
        const int row0 = u.pm * 256 + wr * 64 + fr, c0 = u.pn * 256 + wc * 64 + fq * 8;
#pragma unroll
        for (int ai = 0; ai < 2; ++ai)
#pragma unroll
            for (int mh = 0; mh < 2; ++mh) {
                u32x4 g[2][2], tb[2][2];
#pragma unroll
                for (int mm = 0; mm < 2; ++mm)
#pragma unroll
                    for (int bj = 0; bj < 2; ++bj) { const size_t r = (size_t)(row0 + ai * 128 + (2 * mh + mm) * 16); const int c = c0 + bj * 32;
                        g[mm][bj] = __builtin_nontemporal_load((const u32x4*)(G + r * 2048 + 1024 + c)); tb[mm][bj] = *(const u32x4*)((const bf16_t*)T1 + r * 1024 + c); }
#pragma unroll
                for (int mm = 0; mm < 2; ++mm)
#pragma unroll
                    for (int bj = 0; bj < 2; ++bj) { const int m = 2 * mh + mm; const size_t r = (size_t)(row0 + ai * 128 + m * 16); const int c = c0 + bj * 32;
                        const u32x4 gg = g[mm][bj]; const f32x4 a0 = acc[ai][bj][m][0], a1 = acc[ai][bj][m][1]; const u32x4 tt = tb[mm][bj];
                        const f32x4 x0 = {bf_lo(tt.x), bf_hi(tt.x), bf_lo(tt.y), bf_hi(tt.y)}, x1 = {bf_lo(tt.z), bf_hi(tt.z), bf_lo(tt.w), bf_hi(tt.w)};
                        float v[8] = {x0[0] + bf_lo(gg.x) * a0[0], x0[1] + bf_hi(gg.x) * a0[1], x0[2] + bf_lo(gg.y) * a0[2], x0[3] + bf_hi(gg.y) * a0[3],
                                      x1[0] + bf_lo(gg.z) * a1[0], x1[1] + bf_hi(gg.z) * a1[1], x1[2] + bf_lo(gg.w) * a1[2], x1[3] + bf_hi(gg.w) * a1[3]};
                        *(u32x4*)(MG + r * 1024 + c) = pack8(v); }
            }
    }
};
struct EpiOut {
    static constexpr bool PERM = true, AFTER_DRAIN = false;
    const float* xp; const float* xs; float* X1; bf16_t* X1b; float* SS;
    __device__ __forceinline__ void operator()(const f32x4 (&acc)[2][2][4][2], const pg8::Unit& u, int wr, int wc, int fr, int fq) const {
        const int row0 = u.pm * 256 + wr * 64 + fr, c0 = u.pn * 256 + wc * 64 + fq * 8;
#pragma unroll
        for (int ai = 0; ai < 2; ++ai) {
            f32x4 xv[4][2][2];
#pragma unroll
            for (int m = 0; m < 4; ++m) { const int row = row0 + ai * 128 + m * 16;
                const float* xr = (row < RC) ? xp + (size_t)row * 1024 : xs + (size_t)(row - RC) * 1024;
#pragma unroll
                for (int bj = 0; bj < 2; ++bj) { xv[m][bj][0] = __builtin_nontemporal_load((const f32x4*)(xr + c0 + bj * 32)); xv[m][bj][1] = __builtin_nontemporal_load((const f32x4*)(xr + c0 + bj * 32 + 4)); } }
#pragma unroll
            for (int m = 0; m < 4; ++m) { const int row = row0 + ai * 128 + m * 16;
                float ss = 0.f;
#pragma unroll
                for (int bj = 0; bj < 2; ++bj) { const int c = c0 + bj * 32;
                    const f32x4 a0 = acc[ai][bj][m][0] + xv[m][bj][0], a1 = acc[ai][bj][m][1] + xv[m][bj][1];
                    *(f32x4*)(X1 + (size_t)row * 1024 + c) = a0; *(f32x4*)(X1 + (size_t)row * 1024 + c + 4) = a1;
                    float v[8] = {a0[0], a0[1], a0[2], a0[3], a1[0], a1[1], a1[2], a1[3]};
                    *(u32x4*)(X1b + (size_t)row * 1024 + c) = pack8(v);
#pragma unroll
                    for (int i = 0; i < 8; ++i) ss += v[i] * v[i]; }
                ss += __shfl_xor(ss, 16); ss += __shfl_xor(ss, 32);
                if (fq == 0) SS[(size_t)row * 16 + u.pn * 4 + wc] = ss; }
        }
    }
};
struct EpiFF1 {
    static constexpr bool PERM = true, AFTER_DRAIN = false;
    const float* SS; bf16_t* H;
    __device__ __forceinline__ void operator()(const f32x4 (&acc)[2][2][4][2], const pg8::Unit& u, int wr, int wc, int fr, int fq) const {
        const int row0 = u.pm * 256 + wr * 64 + fr, c0 = u.pn * 256 + wc * 64 + fq * 8;
#pragma unroll
        for (int ai = 0; ai < 2; ++ai) {
            f32x4 sv[4][4];
#pragma unroll
            for (int m = 0; m < 4; ++m) { const f32x4* sp = (const f32x4*)(SS + (size_t)(row0 + ai * 128 + m * 16) * 16);
#pragma unroll
                for (int i = 0; i < 4; ++i) sv[m][i] = sp[i]; }
#pragma unroll
            for (int m = 0; m < 4; ++m) { const int row = row0 + ai * 128 + m * 16;
                const f32x4 s0 = sv[m][0], s1 = sv[m][1], s2 = sv[m][2], s3 = sv[m][3];
                const float s = ((s0[0] + s0[1]) + (s0[2] + s0[3])) + ((s1[0] + s1[1]) + (s1[2] + s1[3])) + ((s2[0] + s2[1]) + (s2[2] + s2[3])) + ((s3[0] + s3[1]) + (s3[2] + s3[3]));
                const float r2 = 1.0f / (s * (1.0f / 1024.0f) + EPS);
#pragma unroll
                for (int bj = 0; bj < 2; ++bj) { float v[8];
#pragma unroll
                    for (int n = 0; n < 2; ++n)
#pragma unroll
                        for (int e = 0; e < 4; ++e) { const float a = fmaxf(acc[ai][bj][m][n][e], 0.f); v[4 * n + e] = a * a * r2; }
                    *(u32x4*)(H + (size_t)row * 4096 + c0 + bj * 32) = pack8(v); } }
        }
    }
};
struct EpiFF2 {
    static constexpr bool PERM = true, AFTER_DRAIN = false;
    const float* X1; float* out;
    __device__ __forceinline__ void operator()(const f32x4 (&acc)[2][2][4][2], const pg8::Unit& u, int wr, int wc, int fr, int fq) const {
        const int row0 = u.pm * 256 + wr * 64 + fr, c0 = u.pn * 256 + wc * 64 + fq * 8;
#pragma unroll
        for (int ai = 0; ai < 2; ++ai) {
            f32x4 xv[4][2][2];
#pragma unroll
            for (int m = 0; m < 4; ++m) { const float* xr = X1 + (size_t)(row0 + ai * 128 + m * 16) * 1024 + c0;
#pragma unroll
                for (int bj = 0; bj < 2; ++bj) { xv[m][bj][0] = __builtin_nontemporal_load((const f32x4*)(xr + bj * 32)); xv[m][bj][1] = __builtin_nontemporal_load((const f32x4*)(xr + bj * 32 + 4)); } }
#pragma unroll
            for (int m = 0; m < 4; ++m) { const int row = row0 + ai * 128 + m * 16;
                float* dst = (row < RC) ? out + O_Y + (size_t)row * 1024 : out + O_YS + (size_t)(row - RC) * 1024;
#pragma unroll
                for (int bj = 0; bj < 2; ++bj) { const int c = c0 + bj * 32;
                    __builtin_nontemporal_store(acc[ai][bj][m][0] + xv[m][bj][0], (f32x4*)(dst + c)); __builtin_nontemporal_store(acc[ai][bj][m][1] + xv[m][bj][1], (f32x4*)(dst + c + 4)); } }
        }
    }
};

__device__ __forceinline__ void p0_transpose_item(const float* W, int K, int N, bf16_t* WT, const float* gk, LAS float* scr, int item, int lane, int kmask = 0x7fffffff, float gscale = 1.0f) {
    const int nblk = N / 32, kb = item / nblk, nb = item % nblk, k0 = 64 * kb, n0 = 32 * nb;
    { f32x4 v[8];
#pragma unroll
      for (int i = 0; i < 8; ++i) v[i] = __builtin_nontemporal_load((const f32x4*)(W + (size_t)(k0 + 8 * i + (lane >> 3)) * N + n0 + 4 * (lane & 7)));
#pragma unroll
      for (int i = 0; i < 8; ++i) { const int kk = 8 * i + (lane >> 3); const float g = gk ? gk[(k0 + kk) & kmask] * gscale : 1.0f;
#pragma unroll
          for (int j = 0; j < 4; ++j) scr[kk * 33 + 4 * (lane & 7) + j] = v[i][j] * g; } }
    asm volatile("s_waitcnt lgkmcnt(0)" ::: "memory");
    const int q = (n0 & 255) >> 5; const int n0p = (n0 & ~255) + 32 * (4 * (q & 1) + (q >> 1));
    const int c = lane & 7;
#pragma unroll
    for (int j = 0; j < 4; ++j) { const int n = (lane >> 3) + 8 * j; const LAS float* s = scr + (8 * c) * 33 + n;
        u32x4 o; o.x = cvtpk(s[0 * 33], s[1 * 33]); o.y = cvtpk(s[2 * 33], s[3 * 33]); o.z = cvtpk(s[4 * 33], s[5 * 33]); o.w = cvtpk(s[6 * 33], s[7 * 33]);
        *(u32x4*)(WT + (size_t)(n0p + n) * K + k0 + 8 * c) = o; }
    asm volatile("s_waitcnt lgkmcnt(0)" ::: "memory");
}

__device__ __forceinline__ void prologue(KArgs a, LAS unsigned char* lds, int vcu, int G) {
    const int tid = opaque_tid(), lane = tid & 63, wave = tid >> 6;
    unsigned char* ws = a->ws;
    LAS float* scr = (LAS float*)(lds + wave * 16384);
    const int gw = vcu * 8 + wave, NGW = G * 8;
    constexpr int I_IN = 16 * 208;
    for (int it = gw; it < I_IN; it += NGW) p0_transpose_item(a->in[I_WIN], 1024, NIN, (bf16_t*)(ws + WS_WIN), nullptr, scr, it, lane);
    const f32x4* gm = (const f32x4*)a->in[I_GMIX] + lane;
    bf16_t* XN = (bf16_t*)(ws + WS_XN);
    for (int row = gw; row < M1; row += NGW) {
        unsigned long long* o8 = (unsigned long long*)(XN + (size_t)row * 1024) + lane;
        if (row >= R1) {
#pragma unroll
            for (int j = 0; j < 4; ++j) o8[64 * j] = 0ull;
            continue; }
        const float* src;
        if (row < RP) { const int b = row / TP, t = row - b * TP; src = (t < NMETA) ? a->in[I_META] + (size_t)t * 1024 : a->in[I_XP] + ((size_t)b * SEQ + (t - NMETA)) * 1024; }
        else src = a->in[I_XS] + (size_t)(row - RP) * 1024;
        const f32x4* xr = (const f32x4*)src + lane;
        f32x4 v[4]; float s = 0.f;
#pragma unroll
        for (int j = 0; j < 4; ++j) { v[j] = __builtin_nontemporal_load(xr + 64 * j); s += (v[j][0] * v[j][0] + v[j][1] * v[j][1]) + (v[j][2] * v[j][2] + v[j][3] * v[j][3]); }
        const float rstd = rsqrtf(wave_sum(s) * (1.0f / 1024.0f) + EPS);
#pragma unroll
        for (int j = 0; j < 4; ++j) { const f32x4 g = gm[64 * j]; const f32x4 y = v[j] * rstd * g;
            o8[64 * j] = (unsigned long long)cvtpk(y[0], y[1]) | ((unsigned long long)cvtpk(y[2], y[3]) << 32); }
    }
    float* rope = (float*)(ws + WS_ROPE);
    for (int e = vcu * 512 + tid; e < (PAST + DS) * 8; e += G * 512) {
        const int pos = e >> 3, i = e & 7;
        const float inv = (i == 0) ? 1.0f : (i == 1) ? 0.1939227432012558f : (i == 2) ? 0.03760603070259094f : (i == 3) ? 0.007292664609849453f :
                          (i == 4) ? 0.0014142135623842478f : (i == 5) ? 0.00027424818836152554f : (i == 6) ? 5.318296098266728e-05f : 1.0313386155758053e-05f;
        const float ang = (float)pos * inv;
        double rev = (double)ang * 0.15915494309189535; rev -= floor(rev);
        const float rf = (float)rev;
        rope[pos * 16 + i] = __builtin_amdgcn_cosf(rf); rope[pos * 16 + 8 + i] = __builtin_amdgcn_sinf(rf);
    }
}

__device__ __forceinline__ void convert_late_weights(KArgs a, LAS unsigned char* lds, int idx, int n) {
    const int tid = opaque_tid(), lane = tid & 63, wave = tid >> 6;
    unsigned char* ws = a->ws;
    LAS float* scr = (LAS float*)(lds + wave * 16384);
    constexpr int I_DO = 16 * 32, I_SO = 8 * 32, I_OUT = 16 * 32, I_F1 = 16 * 128, I_F2 = 64 * 32;
    constexpr int NITEMS = I_DO + I_SO + I_OUT + I_F1 + I_F2;
    for (int it = idx * 8 + wave; it < NITEMS; it += n * 8) {
        int r = it;
        if (r < I_DO) { p0_transpose_item(a->in[I_WDO], 1024, 1024, (bf16_t*)(ws + WS_WDO), a->in[I_SUBG], scr, r, lane, 127, 1.0f - LAM_INIT); continue; } r -= I_DO;
        if (r < I_SO) { p0_transpose_item(a->in[I_WSO], 512, 1024, (bf16_t*)(ws + WS_WSO), nullptr, scr, r, lane); continue; } r -= I_SO;
        if (r < I_OUT) { p0_transpose_item(a->in[I_WOUT], 1024, 1024, (bf16_t*)(ws + WS_WOUT), nullptr, scr, r, lane); continue; } r -= I_OUT;
        if (r < I_F1) { p0_transpose_item(a->in[I_W1], 1024, DFF, (bf16_t*)(ws + WS_W1), a->in[I_GFFN], scr, r, lane); continue; } r -= I_F1;
        p0_transpose_item(a->in[I_W2], DFF, 1024, (bf16_t*)(ws + WS_W2), nullptr, scr, r, lane);
    }
}

constexpr int ATT_STAGE = 34816, ATT_VOFF = 17408, ATT_WSF = 2 * ATT_STAGE, ATT_QOFF = ATT_WSF + 2048;
#define MFMA32(a, b, c) __builtin_amdgcn_mfma_f32_32x32x16_bf16((a), (b), (c), 0, 0, 0)

__device__ __forceinline__ float rowmax32(const f32x16& p0, const f32x16& p1) {
    float a = fmaxf(p0[0], p1[0]);
#pragma unroll
    for (int r = 1; r < 16; ++r) a = fmaxf(a, fmaxf(p0[r], p1[r]));
    return fmaxf(a, __shfl_xor(a, 32));
}
__device__ __forceinline__ void packP(const f32x16& p0, const f32x16& p1, bf16x8 (&pa)[4]) {
    u32x4 w;
    w = (u32x4){cvtpk(p0[0], p0[1]), cvtpk(p0[2], p0[3]), cvtpk(p0[4], p0[5]), cvtpk(p0[6], p0[7])}; pa[0] = __builtin_bit_cast(bf16x8, w);
    w = (u32x4){cvtpk(p0[8], p0[9]), cvtpk(p0[10], p0[11]), cvtpk(p0[12], p0[13]), cvtpk(p0[14], p0[15])}; pa[1] = __builtin_bit_cast(bf16x8, w);
    w = (u32x4){cvtpk(p1[0], p1[1]), cvtpk(p1[2], p1[3]), cvtpk(p1[4], p1[5]), cvtpk(p1[6], p1[7])}; pa[2] = __builtin_bit_cast(bf16x8, w);
    w = (u32x4){cvtpk(p1[8], p1[9]), cvtpk(p1[10], p1[11]), cvtpk(p1[12], p1[13]), cvtpk(p1[14], p1[15])}; pa[3] = __builtin_bit_cast(bf16x8, w);
}

constexpr int D1_VOFF = 17408, D1_QOFF = 2 * ATT_STAGE + 2048;
__device__ __forceinline__ void diff_unit1(KArgs a, LAS unsigned char* lds, int b, int h, int qb, float lam) {
    const int tid = opaque_tid(), lane = tid & 63, r32 = lane & 31, hi = lane >> 5;
    const int wid = __builtin_amdgcn_readfirstlane(tid >> 6);
    unsigned char* ws = a->ws;
    const int rowb = b * TP;
    const int q0 = NMETA + 256 * qb + 32 * wid;
    const int jmax = 4 * qb + 4, jw = 4 * qb + (wid >> 1) + 1;
    const bf16_t* Kb = (const bf16_t*)(ws + WS_KD) + (size_t)rowb * 1024 + h * 128;
    const bf16_t* Vb = (const bf16_t*)(ws + WS_VD) + (size_t)rowb * 1024 + h * 128;
    LAS unsigned char* qlds = lds + D1_QOFF + wid * 8192 + lane * 16;
    { const bf16_t* Qp = (const bf16_t*)(ws + WS_QD) + (size_t)(rowb + q0 + r32) * 1024 + h * 128 + hi * 8;
#pragma unroll
      for (int s = 0; s < 2; ++s)
#pragma unroll
          for (int d0 = 0; d0 < 4; ++d0) *(LAS bf16x8*)(qlds + (s * 4 + d0) * 1024) = *(const bf16x8*)(Qp + s * 64 + d0 * 16); }
    f32x16 o[2][4];
#pragma unroll
    for (int s = 0; s < 2; ++s)
#pragma unroll
        for (int d0 = 0; d0 < 4; ++d0)
#pragma unroll
            for (int r = 0; r < 16; ++r) o[s][d0][r] = 0.f;
    float ls[2] = {0.f, 0.f};
    int never = 0; asm volatile("" : "+s"(never));
    LAS float* wsf = (LAS float*)(lds + ATT_WSF) + wid * 64;
    const int kkv = tid >> 4, kdc = tid & 15;
    const int vkp = tid & 31, vdc = tid >> 5;
    u32x4 kr[2], vr[2];
#define DA_GLOAD(j) do { \
        _Pragma("unroll") for (int i_ = 0; i_ < 2; ++i_) { int pos_ = 64 * (j) - 48 + kkv + 32 * i_; pos_ = pos_ < 0 ? 0 : pos_; kr[i_] = *(const u32x4*)(Kb + (size_t)pos_ * 1024 + kdc * 8); } \
        _Pragma("unroll") for (int i_ = 0; i_ < 2; ++i_) { int pos_ = 64 * (j) - 48 + 2 * vkp + i_; pos_ = pos_ < 0 ? 0 : pos_; vr[i_] = *(const u32x4*)(Vb + (size_t)pos_ * 1024 + vdc * 8); } } while (0)
#define DA_LSTORE(st_) do { LAS unsigned char* sb_ = lds + (st_) * ATT_STAGE; \
        _Pragma("unroll") for (int i_ = 0; i_ < 2; ++i_) *(LAS u32x4*)(sb_ + (kkv + 32 * i_) * 272 + kdc * 16) = kr[i_]; \
        _Pragma("unroll") for (int e_ = 0; e_ < 8; ++e_) { const unsigned lo_ = (vr[0][e_ >> 1] >> (16 * (e_ & 1))) & 0xffffu, hi_ = (vr[1][e_ >> 1] >> (16 * (e_ & 1))) & 0xffffu; \
            *(LAS unsigned*)(sb_ + D1_VOFF + (8 * vdc + e_) * 136 + vkp * 4) = lo_ | (hi_ << 16); } } while (0)
    DA_GLOAD(0); DA_LSTORE(0);
    __syncthreads();
    for (int j = 0; j <= jmax; ++j) {
        if (j < jmax) DA_GLOAD(j + 1);
        if (j <= jw) {
            const LAS unsigned char* Ks = lds + (j & 1) * ATT_STAGE + r32 * 272 + hi * 16;
            const LAS unsigned char* Vs = lds + (j & 1) * ATT_STAGE + D1_VOFF + r32 * 136 + hi * 8;
#pragma unroll
            for (int s = 0; s < 2; ++s) {
#pragma unroll
                for (int hf = 0; hf < 2; ++hf) {
                    if (j == 0 && hf == 0) continue;
                    f32x16 p;
#pragma unroll
                    for (int r = 0; r < 16; ++r) p[r] = 0.f;
#pragma unroll
                    for (int d0 = 0; d0 < 4; ++d0) {
                        const bf16x8 ka = *(const LAS bf16x8*)(Ks + hf * 32 * 272 + s * 128 + d0 * 32);
                        const bf16x8 qf = *(const LAS bf16x8*)(qlds + (s * 4 + d0) * 1024);
                        p = MFMA32(ka, qf, p); }
                    if (j == 0) {
#pragma unroll
                        for (int r = 0; r < 16; ++r) if (crow(r, hi) < 16) p[r] = -INFINITY; }
                    if (never) asm volatile("s_nop 0");
                    float sum = 0.f;
#pragma unroll
                    for (int r = 0; r < 16; ++r) { p[r] = ex2(p[r]); sum += p[r]; }
                    ls[s] += sum;
                    u32x4 w0 = {cvtpk(p[0], p[1]), cvtpk(p[2], p[3]), cvtpk(p[4], p[5]), cvtpk(p[6], p[7])}, w1 = {cvtpk(p[8], p[9]), cvtpk(p[10], p[11]), cvtpk(p[12], p[13]), cvtpk(p[14], p[15])};
                    const bf16x8 pa0 = __builtin_bit_cast(bf16x8, w0), pa1 = __builtin_bit_cast(bf16x8, w1);
                    {
                        const unsigned vb_ = (unsigned)(size_t)(Vs) + hf * 64;
                        const unsigned vb0 = vb_, vb1 = vb_ + 4352, vb2 = vb_ + 2 * 4352, vb3 = vb_ + 3 * 4352;
                        u32x4 fa, fb;
#define VRD(dst_, base_, k_) asm volatile("ds_read2_b64 %0, %1 offset0:%2 offset1:%3" : "=v"(dst_) : "v"(base_), "n"((k_) * 4), "n"((k_) * 4 + 2) : "memory")
#define VWT(n_, dst_) asm volatile("s_waitcnt lgkmcnt(" #n_ ")" : "+v"(dst_) :: "memory")
                        VRD(fa, vb0, 0); VRD(fb, vb0, 1);
                        VWT(1, fa); o[s][0] = MFMA32(pa0, __builtin_bit_cast(bf16x8, fa), o[s][0]); VRD(fa, vb1, 0);
                        VWT(1, fb); o[s][0] = MFMA32(pa1, __builtin_bit_cast(bf16x8, fb), o[s][0]); VRD(fb, vb1, 1);
                        VWT(1, fa); o[s][1] = MFMA32(pa0, __builtin_bit_cast(bf16x8, fa), o[s][1]); VRD(fa, vb2, 0);
                        VWT(1, fb); o[s][1] = MFMA32(pa1, __builtin_bit_cast(bf16x8, fb), o[s][1]); VRD(fb, vb2, 1);
                        VWT(1, fa); o[s][2] = MFMA32(pa0, __builtin_bit_cast(bf16x8, fa), o[s][2]); VRD(fa, vb3, 0);
                        VWT(1, fb); o[s][2] = MFMA32(pa1, __builtin_bit_cast(bf16x8, fb), o[s][2]); VRD(fb, vb3, 1);
                        VWT(1, fa); o[s][3] = MFMA32(pa0, __builtin_bit_cast(bf16x8, fa), o[s][3]);
                        VWT(0, fb); o[s][3] = MFMA32(pa1, __builtin_bit_cast(bf16x8, fb), o[s][3]);
#undef VRD
#undef VWT
                    }
                }
            }
        }
        if (j < jmax) DA_LSTORE((j + 1) & 1);
        __syncthreads();
    }
#undef DA_GLOAD
#undef DA_LSTORE
    ls[0] += __shfl_xor(ls[0], 32); ls[1] += __shfl_xor(ls[1], 32);
    if (hi == 0) { wsf[r32] = 1.0f / ls[0]; wsf[32 + r32] = lam / ls[1]; }
    bf16_t* Od = (bf16_t*)(ws + WS_OD) + (size_t)(b * SEQ + 256 * qb + 32 * wid) * 1024 + h * 128 + r32;
#pragma unroll
    for (int r = 0; r < 16; ++r) {
        const float f1 = wsf[crow(r, hi)], f2 = wsf[32 + crow(r, hi)];
        float v[4]; float ss = 0.f;
#pragma unroll
        for (int d0 = 0; d0 < 4; ++d0) { v[d0] = o[0][d0][r] * f1 - o[1][d0][r] * f2; ss += v[d0] * v[d0]; }
#pragma unroll
        for (int off = 1; off < 32; off <<= 1) ss += __shfl_xor(ss, off);
        const float rstd = rsqrtf(ss * (1.0f / 128.0f) + EPS);
#pragma unroll
        for (int d0 = 0; d0 < 4; ++d0) Od[(size_t)crow(r, hi) * 1024 + 32 * d0] = (bf16_t)(cvtpk(v[d0] * rstd, 0.f) & 0xffffu);
    }
}

__device__ __forceinline__ void sb_weights(f32x16& z0, f32x16& z1, float& R, int hi) {
    f32x16 s0, s1;
#pragma unroll
    for (int r = 0; r < 16; ++r) { z0[r] = ex2(z0[r]); z1[r] = ex2(z1[r]); s0[r] = __builtin_amdgcn_rcpf(1.0f + z0[r]); s1[r] = __builtin_amdgcn_rcpf(1.0f + z1[r]); }
    float gs[8], pg[8], off[8];
#pragma unroll
    for (int g = 0; g < 4; ++g) { gs[g] = (s0[4 * g] * s0[4 * g + 1]) * (s0[4 * g + 2] * s0[4 * g + 3]); gs[4 + g] = (s1[4 * g] * s1[4 * g + 1]) * (s1[4 * g + 2] * s1[4 * g + 3]); }
#pragma unroll
    for (int g = 0; g < 8; ++g) pg[g] = __shfl_xor(gs[g], 32);
    float run = ex2(-R);
#pragma unroll
    for (int g = 7; g >= 0; --g) { off[g] = run * (hi == 0 ? pg[g] : 1.0f); run *= gs[g] * pg[g]; }
    float tp = 1.0f;
#pragma unroll
    for (int g = 0; g < 8; ++g) tp *= gs[g] * pg[g];
    R -= lg2(tp);
#pragma unroll
    for (int g = 0; g < 4; ++g) {
        float c = off[g];
#pragma unroll
        for (int e = 3; e >= 0; --e) { c *= s0[4 * g + e]; z0[4 * g + e] *= c; }
        c = off[4 + g];
#pragma unroll
        for (int e = 3; e >= 0; --e) { c *= s1[4 * g + e]; z1[4 * g + e] *= c; }
    }
}

constexpr int SB_VOFF = 9216;
__device__ __forceinline__ void sb_unit(KArgs a, LAS unsigned char* lds, int b, int h, int qb) {
    const int tid = opaque_tid(), lane = tid & 63, r32 = lane & 31, hi = lane >> 5;
    const int wid = __builtin_amdgcn_readfirstlane(tid >> 6);
    unsigned char* ws = a->ws;
    const int rowb = b * TP;
    const int q0 = NMETA + 256 * qb + 32 * wid;
    const int jmax = 4 * qb + 4, jw = 4 * qb + (wid >> 1) + 1;
    const bf16_t* Kb = (const bf16_t*)(ws + WS_KS) + (size_t)rowb * 512 + h * 64;
    const bf16_t* Vb = (const bf16_t*)(ws + WS_VS) + (size_t)rowb * 512 + h * 64;
    bf16x8 q[4];
    { const bf16_t* Qp = (const bf16_t*)(ws + WS_QS) + (size_t)(rowb + q0 + r32) * 512 + h * 64 + hi * 8;
#pragma unroll
      for (int d0 = 0; d0 < 4; ++d0) q[d0] = *(const bf16x8*)(Qp + d0 * 16); }
    f32x16 o[2];
#pragma unroll
    for (int d0 = 0; d0 < 2; ++d0)
#pragma unroll
        for (int r = 0; r < 16; ++r) o[d0][r] = 0.f;
    float R = 0.f;
    const int kkv = tid >> 3, kdc = tid & 7;
    const int vkp = tid & 31, vdc = (tid >> 5) & 7;
    u32x4 kr, vr[2];
#define SB_GLOAD(j) do { \
        { int pos_ = 64 * (j) - 48 + kkv; pos_ = pos_ < 0 ? 0 : pos_; kr = *(const u32x4*)(Kb + (size_t)pos_ * 512 + kdc * 8); } \
        if (tid < 256) { _Pragma("unroll") for (int i_ = 0; i_ < 2; ++i_) { int pos_ = 64 * (j) - 48 + 2 * vkp + i_; pos_ = pos_ < 0 ? 0 : pos_; vr[i_] = *(const u32x4*)(Vb + (size_t)pos_ * 512 + vdc * 8); } } } while (0)
#define SB_LSTORE(s) do { LAS unsigned char* sb_ = lds + (s) * ATT_STAGE; \
        *(LAS u32x4*)(sb_ + kkv * 144 + kdc * 16) = kr; \
        if (tid < 256) { _Pragma("unroll") for (int e_ = 0; e_ < 8; ++e_) { const unsigned lo_ = (vr[0][e_ >> 1] >> (16 * (e_ & 1))) & 0xffffu, hi_ = (vr[1][e_ >> 1] >> (16 * (e_ & 1))) & 0xffffu; \
            *(LAS unsigned*)(sb_ + SB_VOFF + (8 * vdc + e_) * 136 + vkp * 4) = lo_ | (hi_ << 16); } } } while (0)
    SB_GLOAD(jmax); SB_LSTORE(0);
    __syncthreads();
    int st = 0;
    for (int j = jmax; j >= 0; --j) {
        if (j > 0) SB_GLOAD(j - 1);
        if (j <= jw) {
            const LAS unsigned char* Ks = lds + st * ATT_STAGE + r32 * 144 + hi * 16;
            const LAS unsigned char* Vs = lds + st * ATT_STAGE + SB_VOFF + r32 * 136 + hi * 8;
            f32x16 p0, p1;
#pragma unroll
            for (int r = 0; r < 16; ++r) { p0[r] = 0.f; p1[r] = 0.f; }
#pragma unroll
            for (int d0 = 0; d0 < 4; ++d0) {
                const bf16x8 ka = *(const LAS bf16x8*)(Ks + d0 * 32), kb = *(const LAS bf16x8*)(Ks + 32 * 144 + d0 * 32);
                p0 = MFMA32(ka, q[d0], p0); p1 = MFMA32(kb, q[d0], p1); }
            if (j == jw) { const int qrel = 32 * (wid & 1) + r32; asm volatile("" ::: "memory");
#pragma unroll
                for (int r = 0; r < 16; ++r) { if (crow(r, hi) >= qrel) p0[r] = -INFINITY; if (crow(r, hi) + 32 >= qrel) p1[r] = -INFINITY; } }
            if (j == 0) { asm volatile("" ::: "memory");
#pragma unroll
                for (int r = 0; r < 16; ++r) { p0[r] = -INFINITY; if (crow(r, hi) < 16) p1[r] = -INFINITY; } }
            sb_weights(p0, p1, R, hi);
            bf16x8 pa[4]; packP(p0, p1, pa);
            {
                const unsigned vb0 = (unsigned)(size_t)(Vs), vb1 = vb0 + 4352;
                u32x4 fa, fb;
#define VRD(dst_, base_, k_) asm volatile("ds_read2_b64 %0, %1 offset0:%2 offset1:%3" : "=v"(dst_) : "v"(base_), "n"((k_) * 4), "n"((k_) * 4 + 2) : "memory")
#define VWT(n_, dst_) asm volatile("s_waitcnt lgkmcnt(" #n_ ")" : "+v"(dst_) :: "memory")
                VRD(fa, vb0, 0); VRD(fb, vb0, 1);
                VWT(1, fa); o[0] = MFMA32(pa[0], __builtin_bit_cast(bf16x8, fa), o[0]); VRD(fa, vb0, 2);
                VWT(1, fb); o[0] = MFMA32(pa[1], __builtin_bit_cast(bf16x8, fb), o[0]); VRD(fb, vb0, 3);
                VWT(1, fa); o[0] = MFMA32(pa[2], __builtin_bit_cast(bf16x8, fa), o[0]); VRD(fa, vb1, 0);
                VWT(1, fb); o[0] = MFMA32(pa[3], __builtin_bit_cast(bf16x8, fb), o[0]); VRD(fb, vb1, 1);
                VWT(1, fa); o[1] = MFMA32(pa[0], __builtin_bit_cast(bf16x8, fa), o[1]); VRD(fa, vb1, 2);
                VWT(1, fb); o[1] = MFMA32(pa[1], __builtin_bit_cast(bf16x8, fb), o[1]); VRD(fb, vb1, 3);
                VWT(1, fa); o[1] = MFMA32(pa[2], __builtin_bit_cast(bf16x8, fa), o[1]);
                VWT(0, fb); o[1] = MFMA32(pa[3], __builtin_bit_cast(bf16x8, fb), o[1]);
#undef VRD
#undef VWT
            }
        }
        if (j > 0) SB_LSTORE(st ^ 1);
        __syncthreads();
        st ^= 1;
    }
#undef SB_GLOAD
#undef SB_LSTORE
    LAS bf16_t* stg = (LAS bf16_t*)(lds + wid * 4608);
#pragma unroll
    for (int r = 0; r < 16; ++r)
#pragma unroll
        for (int d0 = 0; d0 < 2; ++d0) stg[crow(r, hi) * 72 + 32 * d0 + r32] = (bf16_t)(cvtpk(o[d0][r], 0.f) & 0xffffu);
    bf16_t* Os = (bf16_t*)(ws + WS_OS) + (size_t)(b * SEQ + 256 * qb + 32 * wid) * 512 + h * 64;
#pragma unroll
    for (int i = 0; i < 4; ++i) { const int row = 8 * i + (lane >> 3), ch = lane & 7;
        *(u32x4*)(Os + (size_t)row * 512 + 8 * ch) = *(const LAS u32x4*)(stg + row * 72 + 8 * ch); }
    __syncthreads();
}

__device__ __forceinline__ bf16x8 ld8f(const float* p) { const f32x4 a = __builtin_nontemporal_load((const f32x4*)p), b = __builtin_nontemporal_load((const f32x4*)(p + 4));
    const u32x4 w = {cvtpk(a[0], a[1]), cvtpk(a[2], a[3]), cvtpk(b[0], b[1]), cvtpk(b[2], b[3])}; return __builtin_bit_cast(bf16x8, w); }

__device__ __forceinline__ void sample_unit(KArgs a, LAS unsigned char* lds, int b, int h, int split) {
    const int tid = opaque_tid(), lane = tid & 63, r32 = lane & 31, hi = lane >> 5;
    const int wid = __builtin_amdgcn_readfirstlane(tid >> 6);
    unsigned char* ws = a->ws;
    const int nt = 2;
    const int kbase = split * 1024 + wid * 128;
    const int srow = RP + b * DS;
    float* part = (float*)(ws + WS_PART) + (size_t)((b * 8 + h) * 4 + split) * PART_FLOATS;
    LAS float* wsf = (LAS float*)(lds + 65536) + wid * 64;
    LAS float* accs = (LAS float*)lds;
    LAS float* stat = (LAS float*)(lds + 32768);
    const unsigned koffL = (unsigned)(r32 * 1024 + hi * 8);
    const unsigned voffL4 = (unsigned)(4 * hi * 1024 + 4 * r32);
    int one_ = 1; asm volatile("" : "+s"(one_));
    for (int it_ = 0; it_ < one_; ++it_) { const int s = wid & 1; const int kb4 = split * 1024 + (wid >> 1) * 256;
        bf16x8 q[4];
        { const bf16_t* Qp = (const bf16_t*)(ws + WS_QD) + (size_t)(srow + r32) * 1024 + h * 128 + s * 64 + hi * 8;
#pragma unroll
          for (int d0 = 0; d0 < 4; ++d0) q[d0] = *(const bf16x8*)(Qp + d0 * 16); }
        f32x16 o[4];
#pragma unroll
        for (int d0 = 0; d0 < 4; ++d0)
#pragma unroll
            for (int r = 0; r < 16; ++r) o[d0][r] = 0.f;
        float mx = -INFINITY, ls = 0.f;
        for (int t = 3; t >= 0; --t) {
            const bool isnew = false;
            const float* kt = (isnew ? a->out + O_SDK + (size_t)(b * DS) * 1024 + h * 128 : a->in[I_CDK] + ((size_t)(b * PAST + kb4 + 64 * t) * 8 + h) * 128) + s * 64;
            const float* vt = isnew ? a->out + O_SDV + (size_t)(b * DS) * 1024 + h * 128 : a->in[I_CDV] + ((size_t)(b * PAST + kb4 + 64 * t) * 8 + h) * 128;
            f32x16 p0, p1;
#pragma unroll
            for (int r = 0; r < 16; ++r) { p0[r] = 0.f; p1[r] = 0.f; }
            { bf16x8 ka[4], kb[4];
#pragma unroll
              for (int d0 = 0; d0 < 4; ++d0) { ka[d0] = ld8f(kt + d0 * 16 + koffL); kb[d0] = ld8f(kt + 32 * 1024 + d0 * 16 + koffL); }
#pragma unroll
              for (int d0 = 0; d0 < 4; ++d0) { p0 = MFMA32(ka[d0], q[d0], p0); p1 = MFMA32(kb[d0], q[d0], p1); } }
            if (isnew) {
#pragma unroll
                for (int r = 0; r < 16; ++r) p1[r] = -INFINITY; }
            const float rm = rowmax32(p0, p1);
            if (__any(rm > mx + 8.0f)) {
                const float mn = fmaxf(mx, rm); const float f = ex2(mx - mn); mx = mn; ls *= f;
                if (hi == 0) wsf[r32] = f;
#pragma unroll
                for (int r = 0; r < 16; ++r) { const float fr_ = wsf[crow(r, hi)];
#pragma unroll
                    for (int d0 = 0; d0 < 4; ++d0) o[d0][r] *= fr_; }
            }
            float sum = 0.f;
#pragma unroll
            for (int r = 0; r < 16; ++r) { p0[r] = ex2(p0[r] - mx); p1[r] = ex2(p1[r] - mx); sum += p0[r] + p1[r]; }
            ls += sum;
            bf16x8 pa[4]; packP(p0, p1, pa);
#pragma unroll
            for (int kp = 0; kp < 2; ++kp) {
                if (isnew && kp == 1) break;
                f32x4 v[2][8];
#pragma unroll
                for (int k2 = 0; k2 < 2; ++k2)
#pragma unroll
                    for (int e = 0; e < 8; ++e) v[k2][e] = __builtin_nontemporal_load((const f32x4*)(vt + (16 * (2 * kp + k2) + (e & 3) + 8 * (e >> 2)) * 1024 + voffL4));
#pragma unroll
                for (int k2 = 0; k2 < 2; ++k2)
#pragma unroll
                    for (int d0 = 0; d0 < 4; ++d0) { float t[8];
#pragma unroll
                        for (int e = 0; e < 8; ++e) t[e] = v[k2][e][d0];
                        const u32x4 vv = pack8(t); o[d0] = MFMA32(pa[2 * kp + k2], __builtin_bit_cast(bf16x8, vv), o[d0]); }
            }
        }
        ls += __shfl_xor(ls, 32);
        if (hi == 0) stat[wid * 32 + r32] = mx;
        __syncthreads();
        float mb = stat[s * 32 + r32];
#pragma unroll
        for (int j = 1; j < 4; ++j) mb = fmaxf(mb, stat[(2 * j + s) * 32 + r32]);
        const float fw = ex2(mx - mb);
        if (hi == 0) wsf[r32] = fw;
        LAS float* lacc = stat + 512;
        for (int w = 0; w < 4; ++w) {
            if ((wid >> 1) == w) {
#pragma unroll
                for (int r = 0; r < 16; ++r) { const int qq = crow(r, hi); const float f = wsf[qq];
#pragma unroll
                    for (int d0 = 0; d0 < 4; ++d0) { LAS float* p = accs + (s * 32 + qq) * 128 + 4 * r32 + d0; const float v = o[d0][r] * f; *p = (w == 0) ? v : *p + v; } }
                if (hi == 0) { LAS float* p = lacc + s * 32 + r32; const float v = ls * fw; *p = (w == 0) ? v : *p + v; }
            }
            __syncthreads();
        }
        if (wid < 2 && hi == 0) { part[s * 64 + r32] = mb; part[s * 64 + 32 + r32] = lacc[s * 32 + r32]; }
    }
    for (int i = tid; i < 2048; i += 512) *(f32x4*)(part + 128 + 4 * i) = *(const LAS f32x4*)(accs + 4 * i);
    __syncthreads();
    {
        bf16x8 q[4];
        { const bf16_t* Qp = (const bf16_t*)(ws + WS_QS) + (size_t)(srow + r32) * 512 + h * 64 + hi * 8;
#pragma unroll
          for (int d0 = 0; d0 < 4; ++d0) q[d0] = *(const bf16x8*)(Qp + d0 * 16); }
        f32x16 o[2];
#pragma unroll
        for (int d0 = 0; d0 < 2; ++d0)
#pragma unroll
            for (int r = 0; r < 16; ++r) o[d0][r] = 0.f;
        float R = 0.f;
        const unsigned koffS = (unsigned)(r32 * 512 + hi * 8), voffS2 = (unsigned)(4 * hi * 512 + 2 * r32);
        for (int t = nt - 1; t >= 0; --t) {
            asm volatile("" ::: "memory");
            const bool isnew = (t == 2);
            const float* kt = isnew ? a->out + O_SSK + (size_t)(b * DS) * 512 + h * 64 : a->in[I_CSK] + ((size_t)(b * PAST + kbase + 64 * t) * 8 + h) * 64;
            const float* vt = isnew ? a->out + O_SSV + (size_t)(b * DS) * 512 + h * 64 : a->in[I_CSV] + ((size_t)(b * PAST + kbase + 64 * t) * 8 + h) * 64;
            f32x16 p0, p1;
#pragma unroll
            for (int r = 0; r < 16; ++r) { p0[r] = 0.f; p1[r] = 0.f; }
            { bf16x8 ka[4], kb[4];
#pragma unroll
              for (int d0 = 0; d0 < 4; ++d0) { ka[d0] = ld8f(kt + d0 * 16 + koffS); kb[d0] = ld8f(kt + 32 * 512 + d0 * 16 + koffS); }
#pragma unroll
              for (int d0 = 0; d0 < 4; ++d0) { p0 = MFMA32(ka[d0], q[d0], p0); p1 = MFMA32(kb[d0], q[d0], p1); } }
            if (isnew) {
#pragma unroll
                for (int r = 0; r < 16; ++r) { p1[r] = -INFINITY; if (crow(r, hi) >= r32) p0[r] = -INFINITY; } }
            sb_weights(p0, p1, R, hi);
            bf16x8 pa[4]; packP(p0, p1, pa);
            {
                f32x2_t v[4][8];
#pragma unroll
                for (int ks = 0; ks < 4; ++ks)
#pragma unroll
                    for (int e = 0; e < 8; ++e) v[ks][e] = (isnew && ks >= 2) ? (f32x2_t){0.f, 0.f} : __builtin_nontemporal_load((const f32x2_t*)(vt + (16 * ks + (e & 3) + 8 * (e >> 2)) * 512 + voffS2));
#pragma unroll
                for (int ks = 0; ks < 4; ++ks)
#pragma unroll
                    for (int d0 = 0; d0 < 2; ++d0) { float t[8];
#pragma unroll
                        for (int e = 0; e < 8; ++e) t[e] = v[ks][e][d0];
                        const u32x4 vv = pack8(t); o[d0] = MFMA32(pa[ks], __builtin_bit_cast(bf16x8, vv), o[d0]); }
            }
        }
        if (hi == 0) stat[wid * 32 + r32] = R;
        __syncthreads();
        float offs = 0.f, tot = 0.f;
#pragma unroll
        for (int w = 0; w < 8; ++w) { const float t_ = stat[w * 32 + r32]; tot += t_; if (w > wid) offs += t_; }
        if (hi == 0) wsf[r32] = ex2(-offs);
        for (int w = 0; w < 8; ++w) {
            if (wid == w) {
#pragma unroll
                for (int r = 0; r < 16; ++r) { const int qq = crow(r, hi); const float f = wsf[qq];
#pragma unroll
                    for (int d0 = 0; d0 < 2; ++d0) { LAS float* p = accs + qq * 64 + 2 * r32 + d0; const float v = o[d0][r] * f; *p = (w == 0) ? v : *p + v; } }
            }
            __syncthreads();
        }
        if (tid < 32) part[8320 + tid] = tot;
        { const int i = tid; *(f32x4*)(part + 8352 + 4 * i) = *(const LAS f32x4*)(accs + 4 * i); }
        __syncthreads();
    }
}

__device__ __forceinline__ void sample_combine(KArgs a, LAS unsigned char* lds, int b, int h, float lam) {
    const int tid = opaque_tid(), lane = tid & 63, r32 = lane & 31, hi = lane >> 5;
    const int wid = __builtin_amdgcn_readfirstlane(tid >> 6);
    unsigned char* ws = a->ws;
    const float* part = (const float*)(ws + WS_PART) + (size_t)((b * 8 + h) * 4) * PART_FLOATS;
    LAS float* np = (LAS float*)lds;
    const int srow = RP + b * DS;
    if (wid == 0) {
#pragma unroll
        for (int s = 0; s < 2; ++s) {
            f32x16 p;
#pragma unroll
            for (int r = 0; r < 16; ++r) p[r] = 0.f;
            { const bf16_t* kp = (const bf16_t*)(ws + WS_KD) + (size_t)(srow + r32) * 1024 + h * 128 + s * 64 + hi * 8;
              const bf16_t* qp = (const bf16_t*)(ws + WS_QD) + (size_t)(srow + r32) * 1024 + h * 128 + s * 64 + hi * 8;
#pragma unroll
              for (int d0 = 0; d0 < 4; ++d0) p = MFMA32(*(const bf16x8*)(kp + d0 * 16), *(const bf16x8*)(qp + d0 * 16), p); }
            float m = fmaxf(p[0], p[1]);
#pragma unroll
            for (int r = 2; r < 16; ++r) m = fmaxf(m, p[r]);
            m = fmaxf(m, __shfl_xor(m, 32));
            float l = 0.f;
#pragma unroll
            for (int r = 0; r < 16; ++r) { p[r] = ex2(p[r] - m); l += p[r]; }
            l += __shfl_xor(l, 32);
            const u32x4 w0 = {cvtpk(p[0], p[1]), cvtpk(p[2], p[3]), cvtpk(p[4], p[5]), cvtpk(p[6], p[7])}, w1 = {cvtpk(p[8], p[9]), cvtpk(p[10], p[11]), cvtpk(p[12], p[13]), cvtpk(p[14], p[15])};
            const bf16_t* vp = (const bf16_t*)(ws + WS_VD) + (size_t)(srow + 4 * hi) * 1024 + h * 128 + r32;
#pragma unroll
            for (int d0 = 0; d0 < 4; ++d0) {
                f32x16 o;
#pragma unroll
                for (int r = 0; r < 16; ++r) o[r] = 0.f;
#pragma unroll
                for (int ks = 0; ks < 2; ++ks) { unsigned w[4];
#pragma unroll
                    for (int e2 = 0; e2 < 4; ++e2) { const int e = 2 * e2;
                        const unsigned lo = vp[(size_t)(16 * ks + (e & 3) + 8 * (e >> 2)) * 1024 + 32 * d0], hi_ = vp[(size_t)(16 * ks + ((e + 1) & 3) + 8 * ((e + 1) >> 2)) * 1024 + 32 * d0]; w[e2] = lo | (hi_ << 16); }
                    const u32x4 vv = {w[0], w[1], w[2], w[3]};
                    o = MFMA32(__builtin_bit_cast(bf16x8, ks ? w1 : w0), __builtin_bit_cast(bf16x8, vv), o); }
#pragma unroll
                for (int r = 0; r < 16; ++r) np[128 + (s * 32 + crow(r, hi)) * 128 + 32 * d0 + r32] = o[r];
            }
            if (hi == 0) { np[s * 64 + r32] = m; np[s * 64 + 32 + r32] = l; }
        }
        {
            f32x16 p0, p1;
#pragma unroll
            for (int r = 0; r < 16; ++r) { p0[r] = 0.f; p1[r] = -INFINITY; }
            { const bf16_t* kp = (const bf16_t*)(ws + WS_KS) + (size_t)(srow + r32) * 512 + h * 64 + hi * 8;
              const bf16_t* qp = (const bf16_t*)(ws + WS_QS) + (size_t)(srow + r32) * 512 + h * 64 + hi * 8;
#pragma unroll
              for (int d0 = 0; d0 < 4; ++d0) p0 = MFMA32(*(const bf16x8*)(kp + d0 * 16), *(const bf16x8*)(qp + d0 * 16), p0); }
#pragma unroll
            for (int r = 0; r < 16; ++r) if (crow(r, hi) >= r32) p0[r] = -INFINITY;
            float R = 0.f;
            sb_weights(p0, p1, R, hi);
            const u32x4 w0 = {cvtpk(p0[0], p0[1]), cvtpk(p0[2], p0[3]), cvtpk(p0[4], p0[5]), cvtpk(p0[6], p0[7])}, w1 = {cvtpk(p0[8], p0[9]), cvtpk(p0[10], p0[11]), cvtpk(p0[12], p0[13]), cvtpk(p0[14], p0[15])};
            const bf16_t* vp = (const bf16_t*)(ws + WS_VS) + (size_t)(srow + 4 * hi) * 512 + h * 64 + r32;
#pragma unroll
            for (int d0 = 0; d0 < 2; ++d0) {
                f32x16 o;
#pragma unroll
                for (int r = 0; r < 16; ++r) o[r] = 0.f;
#pragma unroll
                for (int ks = 0; ks < 2; ++ks) { unsigned w[4];
#pragma unroll
                    for (int e2 = 0; e2 < 4; ++e2) { const int e = 2 * e2;
                        const unsigned lo = vp[(size_t)(16 * ks + (e & 3) + 8 * (e >> 2)) * 512 + 32 * d0], hi_ = vp[(size_t)(16 * ks + ((e + 1) & 3) + 8 * ((e + 1) >> 2)) * 512 + 32 * d0]; w[e2] = lo | (hi_ << 16); }
                    const u32x4 vv = {w[0], w[1], w[2], w[3]};
                    o = MFMA32(__builtin_bit_cast(bf16x8, ks ? w1 : w0), __builtin_bit_cast(bf16x8, vv), o); }
#pragma unroll
                for (int r = 0; r < 16; ++r) np[8352 + crow(r, hi) * 64 + 32 * d0 + r32] = o[r];
            }
            if (hi == 0) np[8320 + r32] = R;
        }
    }
    __syncthreads();
    {
        const int qq = tid >> 4, c = tid & 15;
        float v[2][8];
#pragma unroll
        for (int s = 0; s < 2; ++s) {
            float m[5], l[5], M = -INFINITY;
#pragma unroll
            for (int sp = 0; sp < 4; ++sp) { m[sp] = part[sp * PART_FLOATS + s * 64 + qq]; l[sp] = part[sp * PART_FLOATS + s * 64 + 32 + qq]; M = fmaxf(M, m[sp]); }
            m[4] = np[s * 64 + qq]; l[4] = np[s * 64 + 32 + qq]; M = fmaxf(M, m[4]);
            float L = 0.f;
#pragma unroll
            for (int i = 0; i < 8; ++i) v[s][i] = 0.f;
#pragma unroll
            for (int sp = 0; sp < 5; ++sp) { const float f = ex2(m[sp] - M); L += l[sp] * f;
                f32x4 x0, x1;
                if (sp < 4) { const float* op = part + sp * PART_FLOATS + 128 + (s * 32 + qq) * 128 + 8 * c; x0 = *(const f32x4*)op; x1 = *(const f32x4*)(op + 4); }
                else { const LAS float* op = np + 128 + (s * 32 + qq) * 128 + 8 * c; x0 = *(const LAS f32x4*)op; x1 = *(const LAS f32x4*)(op + 4); }
#pragma unroll
                for (int i = 0; i < 4; ++i) { v[s][i] += x0[i] * f; v[s][4 + i] += x1[i] * f; } }
            const float inv = 1.0f / L;
#pragma unroll
            for (int i = 0; i < 8; ++i) v[s][i] *= inv;
        }
        float y[8]; float ss = 0.f;
#pragma unroll
        for (int i = 0; i < 8; ++i) { y[i] = v[0][i] - lam * v[1][i]; ss += y[i] * y[i]; }
#pragma unroll
        for (int off = 1; off < 16; off <<= 1) ss += __shfl_xor(ss, off);
        const float rstd = rsqrtf(ss * (1.0f / 128.0f) + EPS);
#pragma unroll
        for (int i = 0; i < 8; ++i) y[i] *= rstd;
        *(u32x4*)((bf16_t*)(ws + WS_OD) + (size_t)(RC + b * DS + qq) * 1024 + h * 128 + 8 * c) = pack8(y);
    }
    if (tid < 256) {
        const int qq = tid >> 3, c = tid & 7;
        float y[8];
        { const LAS float* op = np + 8352 + qq * 64 + 8 * c; const f32x4 x0 = *(const LAS f32x4*)op, x1 = *(const LAS f32x4*)(op + 4);
#pragma unroll
          for (int i = 0; i < 4; ++i) { y[i] = x0[i]; y[4 + i] = x1[i]; } }
        float offs = np[8320 + qq];
#pragma unroll
        for (int sp = 3; sp >= 0; --sp) { const float f = ex2(-offs);
            const float* op = part + sp * PART_FLOATS + 8352 + qq * 64 + 8 * c; const f32x4 x0 = *(const f32x4*)op, x1 = *(const f32x4*)(op + 4);
#pragma unroll
            for (int i = 0; i < 4; ++i) { y[i] += x0[i] * f; y[4 + i] += x1[i] * f; }
            offs += part[sp * PART_FLOATS + 8320 + qq]; }
        *(u32x4*)((bf16_t*)(ws + WS_OS) + (size_t)(RC + b * DS + qq) * 512 + h * 64 + 8 * c) = pack8(y);
    }
    __syncthreads();
}

__device__ __forceinline__ int phys_row0(int cb) { const int q = cb & 7; return (cb >> 3) * 256 + 32 * (4 * (q & 1) + (q >> 1)); }
__device__ __forceinline__ void skinny_acc(f32x16& acc, const bf16_t* A, const bf16_t* Bt, int K, int row0, int prow0, int wid, int r32, int hi) {
    const int kw = K >> 3;
    const bf16_t* ap = A + (size_t)(row0 + r32) * K + wid * kw + hi * 8;
    const bf16_t* bp = Bt + (size_t)(prow0 + r32) * K + wid * kw + hi * 8;
#pragma unroll 8
    for (int k = 0; k < kw; k += 16) { const bf16x8 av = *(const bf16x8*)(ap + k), bv = *(const bf16x8*)(bp + k); acc = MFMA32(av, bv, acc); }
}
__device__ __forceinline__ void skinny_acc2(f32x16& acc, f32x16& acc2, const bf16_t* A, const bf16_t* Bt, int K, int row0, int prow0, int prow1, int wid, int r32, int hi) {
    const int kw = K >> 3;
    const bf16_t* ap = A + (size_t)(row0 + r32) * K + wid * kw + hi * 8;
    const bf16_t* bp = Bt + (size_t)(prow0 + r32) * K + wid * kw + hi * 8;
    const bf16_t* bq = Bt + (size_t)(prow1 + r32) * K + wid * kw + hi * 8;
#pragma unroll 8
    for (int k = 0; k < kw; k += 16) { const bf16x8 av = *(const bf16x8*)(ap + k), bv = *(const bf16x8*)(bp + k), bw = *(const bf16x8*)(bq + k); acc = MFMA32(av, bv, acc); acc2 = MFMA32(av, bw, acc2); }
}
__device__ __forceinline__ void skinny_put(LAS float* red, const f32x16& acc, int wid, int r32, int hi) {
#pragma unroll
    for (int r = 0; r < 16; ++r) red[(wid * 32 + crow(r, hi)) * 33 + r32] = acc[r];
}
__device__ __forceinline__ void skinny_get(const LAS float* red, int row, int col, float& s0, float& s1) {
    s0 = 0.f; s1 = 0.f;
#pragma unroll
    for (int w = 0; w < 8; ++w) { s0 += red[(w * 32 + row) * 33 + col]; s1 += red[(w * 32 + row) * 33 + col + 1]; }
}
constexpr size_t WS_SSS = WS_SS + 1280 * 1024;
__device__ __forceinline__ void skinny_phase(KArgs a, LAS unsigned char* lds, int which, int vcu, int G) {
    const int tid = opaque_tid(), lane = tid & 63, r32 = lane & 31, hi = lane >> 5;
    const int wid = __builtin_amdgcn_readfirstlane(tid >> 6);
    unsigned char* ws = a->ws;
    LAS float* red = (LAS float*)lds; LAS float* red2 = (LAS float*)(lds + 34816);
    const int row = tid >> 4, col = 2 * (tid & 15);
    const int nunits = (which == 2) ? 512 : 256;
    for (int u = vcu; u < nunits; u += G) {
        const int rb = u & 7; int cb = (which == 2) ? 2 * (u >> 3) : (u >> 3);
        const int row0 = RC + 32 * rb, prow0 = phys_row0(cb);
        const int grow = row0 + row, srow = grow - RC; int gcol = 32 * cb + col;
        f32x16 acc, acc2;
#pragma unroll
        for (int r = 0; r < 16; ++r) { acc[r] = 0.f; acc2[r] = 0.f; }
        if (which == 0) {
            skinny_acc(acc, (const bf16_t*)(ws + WS_OD), (const bf16_t*)(ws + WS_WDO), 1024, row0, prow0, wid, r32, hi);
            skinny_acc(acc2, (const bf16_t*)(ws + WS_OS), (const bf16_t*)(ws + WS_WSO), 512, row0, prow0, wid, r32, hi);
            skinny_put(red, acc, wid, r32, hi); skinny_put(red2, acc2, wid, r32, hi);
        } else if (which == 1) {
            skinny_acc(acc, (const bf16_t*)(ws + WS_XN), (const bf16_t*)(ws + WS_WOUT), 1024, row0, prow0, wid, r32, hi);
            skinny_put(red, acc, wid, r32, hi);
        } else if (which == 2) {
            skinny_acc2(acc, acc2, (const bf16_t*)(ws + WS_OD), (const bf16_t*)(ws + WS_W1), 1024, row0, prow0, phys_row0(cb + 1), wid, r32, hi);
            skinny_put(red, acc, wid, r32, hi); skinny_put(red2, acc2, wid, r32, hi);
        } else {
            skinny_acc(acc, (const bf16_t*)(ws + WS_H), (const bf16_t*)(ws + WS_W2), 4096, row0, prow0, wid, r32, hi);
            skinny_put(red, acc, wid, r32, hi);
        }
        __syncthreads();
        float s0, s1; skinny_get(red, row, col, s0, s1);
        if (which == 0) {
            float t0, t1; skinny_get(red2, row, col, t0, t1);
            const unsigned gd = *(const unsigned*)((const bf16_t*)(ws + WS_G) + (size_t)grow * 2048 + gcol), gs = *(const unsigned*)((const bf16_t*)(ws + WS_G) + (size_t)grow * 2048 + 1024 + gcol);
            *(unsigned*)((bf16_t*)(ws + WS_XN) + (size_t)grow * 1024 + gcol) = cvtpk(bf_lo(gd) * s0 + bf_lo(gs) * t0, bf_hi(gd) * s1 + bf_hi(gs) * t1);
        } else if (which == 1) {
            const float* xr = a->in[I_XS] + (size_t)srow * 1024 + gcol;
            const float v0 = xr[0] + s0, v1 = xr[1] + s1;
            *(f32x2_t*)((float*)(ws + WS_G) + (size_t)grow * 1024 + gcol) = (f32x2_t){v0, v1};
            *(unsigned*)((bf16_t*)(ws + WS_OD) + (size_t)grow * 1024 + gcol) = cvtpk(v0, v1);
            float ss = v0 * v0 + v1 * v1;
#pragma unroll
            for (int off = 1; off < 16; off <<= 1) ss += __shfl_xor(ss, off);
            if ((tid & 15) == 0) ((float*)(ws + WS_SSS))[srow * 32 + cb] = ss;
        } else if (which == 2) {
            const float* sp = (const float*)(ws + WS_SSS) + srow * 32 + col;
            float ss = sp[0] + sp[1];
#pragma unroll
            for (int off = 1; off < 16; off <<= 1) ss += __shfl_xor(ss, off);
            const float r2 = 1.0f / (ss * (1.0f / 1024.0f) + EPS);
            const float h0 = fmaxf(s0, 0.f), h1 = fmaxf(s1, 0.f);
            *(unsigned*)((bf16_t*)(ws + WS_H) + (size_t)grow * 4096 + gcol) = cvtpk(h0 * h0 * r2, h1 * h1 * r2);
            float t0, t1; skinny_get(red2, row, col, t0, t1);
            const float h2 = fmaxf(t0, 0.f), h3 = fmaxf(t1, 0.f);
            *(unsigned*)((bf16_t*)(ws + WS_H) + (size_t)grow * 4096 + gcol + 32) = cvtpk(h2 * h2 * r2, h3 * h3 * r2);
        } else {
            const float* xr = (const float*)(ws + WS_G) + (size_t)grow * 1024 + gcol;
            *(f32x2_t*)(a->out + O_YS + (size_t)srow * 1024 + gcol) = (f32x2_t){xr[0] + s0, xr[1] + s1};
        }
        __syncthreads();
    }
}

#define XB_TMO      128
#define XB_XCNT(j)  (256  + 64 * (j))
#define XB_XSUB(j)  (1280 + 64 * (j))
#define XB_XGEN(j)  (2304 + 64 * (j))
#define XB_TOP      3328
#define XB_TOPGEN   3392
#define XCD_BAR_WORDS 3456
#define XB_SPIN_CAP (1u << 18)

__device__ __forceinline__ unsigned xb_ld(unsigned* p)              { return __hip_atomic_load(p, __ATOMIC_RELAXED, __HIP_MEMORY_SCOPE_AGENT); }
__device__ __forceinline__ unsigned xb_add(unsigned* p, unsigned v) { return __hip_atomic_fetch_add(p, v, __ATOMIC_RELAXED, __HIP_MEMORY_SCOPE_AGENT); }
__device__ __forceinline__ unsigned xb_xcc_id() { return (unsigned)__builtin_amdgcn_s_getreg((3 << 11) | 20) & 0xFu; }
#define XB_SPIN(cond, bar) do { unsigned _sp = 0; while (cond) { __builtin_amdgcn_s_sleep(1); \
    if ((++_sp & 255u) == 0u) { if (xb_ld(&(bar)[XB_TMO])) break; if (_sp > XB_SPIN_CAP) { atomicAdd(&(bar)[XB_TMO], 1u); break; } } } } while (0)

struct XcdBarrier {
    unsigned* bar; unsigned x;
    volatile LAS unsigned* st;
};

__device__ __forceinline__ XcdBarrier xcd_barrier_post(unsigned* bar, volatile LAS unsigned* st) {
    XcdBarrier b; b.bar = bar; b.x = xb_xcc_id(); b.st = st;
    if (threadIdx.x == 0) (void)xb_add(&bar[XB_XCNT(b.x)], 1u);
    return b;
}
__device__ __forceinline__ void xcd_barrier_complete(unsigned* bar, unsigned x, unsigned& nloc, unsigned& nx) {
    const unsigned G = gridDim.x * gridDim.y * gridDim.z;
    unsigned sum, cnt, mine, sp = 0u;
    for (;;) {
        sum = 0u; cnt = 0u; mine = 0u;
#pragma unroll
        for (unsigned j = 0; j < 16; ++j) { const unsigned c = xb_ld(&bar[XB_XCNT(j)]); sum += c; cnt += (c > 0u) ? 1u : 0u; mine = (j == x) ? c : mine; }
        if (sum == G) break;
        __builtin_amdgcn_s_sleep(1);
        if ((++sp & 255u) == 0u) { if (xb_ld(&bar[XB_TMO])) break; if (sp > XB_SPIN_CAP) { atomicAdd(&bar[XB_TMO], 1u); break; } }
    }
    nloc = mine > 0u ? mine : 1u; nx = cnt > 0u ? cnt : 1u;
}

__device__ __forceinline__ void xcd_barrier(const XcdBarrier& b) {
    asm volatile("s_waitcnt vmcnt(0)" ::: "memory");
    __syncthreads();
    if (threadIdx.x == 0) {
        unsigned* bar = b.bar;
        __builtin_amdgcn_s_waitcnt(0);
        unsigned nloc = b.st[0], nx = b.st[1];
        if (nloc == 0u) { xcd_barrier_complete(bar, b.x, nloc, nx); b.st[0] = nloc; b.st[1] = nx; }
        const unsigned old = xb_add(&bar[XB_XSUB(b.x)], 1u);
        const unsigned gen = old / nloc;
        if (old + 1u == (gen + 1u) * nloc) {
            __builtin_amdgcn_fence(__ATOMIC_RELEASE, "agent");
            asm volatile("s_waitcnt vmcnt(0)" ::: "memory");
            const unsigned og = xb_add(&bar[XB_TOP], 1u);
            const unsigned tg = og / nx;
            if (og + 1u == (tg + 1u) * nx) xb_add(&bar[XB_TOPGEN], 1u);
            else XB_SPIN(xb_ld(&bar[XB_TOPGEN]) == tg, bar);
            __builtin_amdgcn_fence(__ATOMIC_ACQUIRE, "agent");
            xb_add(&bar[XB_XGEN(b.x)], 1u);
            asm volatile("s_waitcnt vmcnt(0)" ::: "memory");
        } else {
            XB_SPIN(xb_ld(&bar[XB_XGEN(b.x)]) == gen, bar);
            __builtin_amdgcn_fence(__ATOMIC_ACQUIRE, "agent");
            asm volatile("s_waitcnt vmcnt(0)" ::: "memory");
        }
    }
    __syncthreads();
}

__global__ void __launch_bounds__(512, 2) mega_fwd(Args a_) {
    extern __shared__ __attribute__((aligned(16))) unsigned char lds_raw[];
    LAS unsigned char* lds = (LAS unsigned char*)lds_raw;
    cg::grid_group grid = cg::this_grid();
    const int G = gridDim.x, bx = blockIdx.x;
    const int vcu = (G % 8 == 0) ? (bx % 8) * (G / 8) + bx / 8 : bx;
    KArgs a = (KArgs)__builtin_amdgcn_kernarg_segment_ptr();
#define RELOAD_ARGS() asm volatile("" : "+s"(a))
    unsigned char* ws;

    volatile LAS unsigned* bst = (volatile LAS unsigned*)(lds + LDS_BYTES - 64);
    if (threadIdx.x < 2) bst[threadIdx.x] = 0u;
    RELOAD_ARGS();
    __syncthreads();
    { int never = 0; asm volatile("" : "+s"(never)); if (never) grid.sync(); }
    RELOAD_ARGS();
    (void)xcd_barrier_post((unsigned*)(a->ws + WS_BAR), bst);
#define SEAM() do { RELOAD_ARGS(); XcdBarrier xb_; xb_.bar = (unsigned*)(a->ws + WS_BAR); xb_.x = xb_xcc_id(); xb_.st = bst; xcd_barrier(xb_); } while (0)
    RELOAD_ARGS();
    for (int rep_ = 0; rep_ < REP_P0; ++rep_) prologue(a, lds, vcu, G);
    SEAM();

    for (int rep_ = 0; rep_ < REP_SYNC; ++rep_) SEAM();
    RELOAD_ARGS(); ws = a->ws;
    for (int rep_ = 0; rep_ < REP_P1; ++rep_)
    {
        pg8::Gemm g{(const bf16_t*)(ws + WS_XN), (const bf16_t*)(ws + WS_WIN), M1, NIN, 1024}; pg8::StaticOrder S; S.init(M1, NIN, G, bx);
        EpiIn E{a->out, ws, a->in[I_QG], a->in[I_KG]};
        pg8::gemm_phase<EpiIn, pg8::StaticOrder, true, true>(lds, g, S, E);
    }
    { constexpr int NU = (M1 / 256) * (NIN / 256); const int full = NU / G, first_idle = NU - full * G;
      if (first_idle > 0 && first_idle < G) { if (bx >= first_idle) { RELOAD_ARGS(); convert_late_weights(a, lds, bx - first_idle, G - first_idle); } }
      else { RELOAD_ARGS(); convert_late_weights(a, lds, bx, G); } }
    SEAM();


    RELOAD_ARGS(); ws = a->ws;
    for (int rep_ = 0; rep_ < REP_P2A; ++rep_)
    for (int u = vcu; u < DB * 8 * 4; u += G) { int uu = u; asm volatile("" : "+s"(uu)); RELOAD_ARGS(); sample_unit(a, lds, uu >> 5, (uu >> 2) & 7, uu & 3); }
    SEAM();

    RELOAD_ARGS(); ws = a->ws;
    float lam;
    { const int lane = opaque_tid() & 63;
      const float s1 = wave_sum(a->in[I_LQ1][lane] * a->in[I_LK1][lane]), s2 = wave_sum(a->in[I_LQ2][lane] * a->in[I_LK2][lane]);
      lam = __builtin_bit_cast(float, __builtin_amdgcn_readfirstlane(__builtin_bit_cast(int, __expf(s1) - __expf(s2) + LAM_INIT))); }
    for (int u = vcu; u < DB * 8; u += G) sample_combine(a, lds, u >> 3, u & 7, lam);
    for (int rep_ = 0; rep_ < REP_P2B; ++rep_)
    for (int u = vcu; u < NBATCH * 8 * 8; u += G) {
        const int bh = u >> 3, s = u & 7, b = bh >> 3, h = bh & 7;
        for (int k = 0; k < 2 * REP_DIFF; ++k) { int qb = (k & 1) ? 15 - s : s, bb = b, hh = h; asm volatile("" : "+s"(qb), "+s"(bb), "+s"(hh)); RELOAD_ARGS(); diff_unit1(a, lds, bb, hh, qb, lam); }
        for (int k = 0; k < 2 * REP_SB; ++k) { int qb = (k & 1) ? 15 - s : s, bb = b, hh = h; asm volatile("" : "+s"(qb), "+s"(bb), "+s"(hh)); RELOAD_ARGS(); sb_unit(a, lds, bb, hh, qb); }
    }
    SEAM();

    for (int rep3_ = 0; rep3_ < REP_P3; ++rep3_) {
    RELOAD_ARGS(); ws = a->ws;
    {
        pg8::Gemm g{(const bf16_t*)(ws + WS_OD), (const bf16_t*)(ws + WS_WDO), RC, 1024, 1024}; pg8::StaticOrder S; S.init(RC, 1024, G, bx);
        EpiGateA E{(const bf16_t*)(ws + WS_G), (float*)(ws + WS_T1)};
        pg8::gemm_phase<EpiGateA, pg8::StaticOrder, true, true>(lds, g, S, E);
    }
    __syncthreads();
    RELOAD_ARGS(); ws = a->ws;
    {
        pg8::Gemm g{(const bf16_t*)(ws + WS_OS), (const bf16_t*)(ws + WS_WSO), RC, 1024, 512}; pg8::StaticOrder S; S.init(RC, 1024, G, bx);
        EpiGateB E{(const bf16_t*)(ws + WS_G), (const float*)(ws + WS_T1), (bf16_t*)(ws + WS_XN)};
        pg8::gemm_phase<EpiGateB, pg8::StaticOrder, true, true>(lds, g, S, E);
    }
    RELOAD_ARGS(); skinny_phase(a, lds, 0, vcu, G);
    __syncthreads();
    }
    SEAM();

    RELOAD_ARGS(); ws = a->ws;
    for (int rep_ = 0; rep_ < REP_P4; ++rep_)
    {
        pg8::Gemm g{(const bf16_t*)(ws + WS_XN), (const bf16_t*)(ws + WS_WOUT), RC, 1024, 1024}; pg8::StaticOrder S; S.init(RC, 1024, G, bx);
        EpiOut E{a->in[I_XP], a->in[I_XS], (float*)(ws + WS_G), (bf16_t*)(ws + WS_OD), (float*)(ws + WS_SS)};
        pg8::gemm_phase<EpiOut, pg8::StaticOrder, true, true>(lds, g, S, E);
    }
    RELOAD_ARGS(); skinny_phase(a, lds, 1, vcu, G);
    SEAM();

    RELOAD_ARGS(); ws = a->ws;
    for (int rep_ = 0; rep_ < REP_P5; ++rep_)
    {
        pg8::Gemm g{(const bf16_t*)(ws + WS_OD), (const bf16_t*)(ws + WS_W1), RC, DFF, 1024}; pg8::StaticOrder S; S.init(RC, DFF, G, bx);
        EpiFF1 E{(const float*)(ws + WS_SS), (bf16_t*)(ws + WS_H)};
        pg8::gemm_phase<EpiFF1, pg8::StaticOrder, true, true>(lds, g, S, E);
    }
    RELOAD_ARGS(); skinny_phase(a, lds, 2, vcu, G);
    SEAM();

    RELOAD_ARGS(); ws = a->ws;
    for (int rep_ = 0; rep_ < REP_P6; ++rep_)
    {
        pg8::Gemm g{(const bf16_t*)(ws + WS_H), (const bf16_t*)(ws + WS_W2), RC, 1024, DFF}; pg8::StaticOrder S; S.init(RC, 1024, G, bx);
        EpiFF2 E{(const float*)(ws + WS_G), a->out};
        pg8::gemm_phase<EpiFF2, pg8::StaticOrder, true, true>(lds, g, S, E);
    }
    RELOAD_ARGS(); skinny_phase(a, lds, 3, vcu, G);
}

extern "C" void kernel_launch(void* const* d_in, const int* in_sizes, int n_in, void* d_out, int out_size, void* d_ws, size_t ws_size, hipStream_t stream) {
    static int grid = 0;
    if (grid == 0) {
        if (n_in != 22 || ws_size < WS_END) { fprintf(stderr, "kernel_launch: unexpected n_in %d / ws %zu\n", n_in, ws_size); grid = -1; return; }
        int dev = 0, cus = 0, per_cu = 0;
        hipGetDevice(&dev);
        hipDeviceGetAttribute(&cus, hipDeviceAttributeMultiprocessorCount, dev);
        hipFuncSetAttribute((const void*)mega_fwd, hipFuncAttributeMaxDynamicSharedMemorySize, LDS_BYTES);
        hipOccupancyMaxActiveBlocksPerMultiprocessor(&per_cu, (const void*)mega_fwd, 512, LDS_BYTES);
        if (per_cu < 1) { fprintf(stderr, "kernel_launch: occupancy query says %d blocks/CU\n", per_cu); per_cu = 1; }
        (void)hipGetLastError();
        grid = cus * 1;
    }
    if (grid < 0) return;
    Args a{};
    for (int i = 0; i < 22; ++i) a.in[i] = (const float*)d_in[i];
    a.out = (float*)d_out; a.ws = (unsigned char*)d_ws;
    if (hipMemsetAsync((unsigned char*)d_ws + WS_BAR, 0, XCD_BAR_WORDS * 4, stream) != hipSuccess) { fprintf(stderr, "kernel_launch: hipMemsetAsync failed\n"); return; }
    void* args[] = {&a};
    hipError_t e = hipLaunchCooperativeKernel((const void*)mega_fwd, dim3(grid), dim3(512), args, LDS_BYTES, stream);
    if (e != hipSuccess) fprintf(stderr, "cooperative launch failed: %s (grid %d)\n", hipGetErrorString(e), grid);
}
```

```cpp
#include <hip/hip_runtime.h>
#include <hip/hip_cooperative_groups.h>
#include <cstdio>
#include <cstdint>
namespace cg = cooperative_groups;
__device__ __forceinline__ int opaque_tid() { int t = threadIdx.x; asm volatile("" : "+v"(t)); return t; }
namespace pg8 {
#define PG8_LAS __attribute__((address_space(3)))
typedef unsigned short bf16_t;
typedef short bf16x8 __attribute__((ext_vector_type(8)));
typedef float f32x4 __attribute__((ext_vector_type(4)));
typedef unsigned u32x4 __attribute__((ext_vector_type(4)));
constexpr int BM = 256, BK = 64, HALF = 128, HTB = HALF * BK * 2  , STAGE_BYTES = 8 * HTB, NXCD = 8, WGM = 8;

__host__ __device__ __forceinline__ int lds_byte(int r, int c) { const int st = (r >> 4) * 2 + (c >> 5), rr = r & 15, cc = c & 31, ob = rr * 64 + cc * 2; return st * 1024 + (ob ^ (((ob >> 9) & 1) << 5)); }
__host__ __device__ __forceinline__ void stage_rc(int b, int& R, int& C) { const int st = b / 1024, sb = b % 1024, swz = sb ^ (((sb >> 9) & 1) << 5); R = (st >> 1) * 16 + swz / 64; C = (st & 1) * 32 + (swz % 64) / 2; }
__host__ __device__ __forceinline__ int perm32(int rho) { const int n = rho >> 4, i = rho & 15; return 8 * (i >> 2) + 4 * n + (i & 3); }

struct Unit { int pm, pn; };
struct Gemm { const bf16_t* A; const bf16_t* Bt; int M, N, K; };

struct StaticOrder {
    int nM, nN, nwg, G, c;
    __host__ __device__ void init(int M, int N, int G_, int c_) { nM = M / BM; nN = N / BM; nwg = nM * nN; G = G_; c = c_; }
    __host__ __device__ bool next(int i, Unit& u) const {
        const long L = (long)i * G + c; if (L >= nwg) return false;
        int wgid = (int)L; { const int q = nwg / NXCD, r = nwg % NXCD, xcd = wgid % NXCD, off = wgid / NXCD; wgid = (xcd < r ? xcd * (q + 1) : r * (q + 1) + (xcd - r) * q) + off; }
        const int nig = WGM * nN, gid = wgid / nig, fm = gid * WGM, gsz = (nM - fm) < WGM ? (nM - fm) : WGM;
        u.pm = fm + ((wgid % nig) % gsz); u.pn = (wgid % nig) / gsz; return true;
    }
    __device__ __forceinline__ void a_ready(const Unit&) const {}
    __device__ __forceinline__ void done(const Unit&) const {}
};

__device__ __forceinline__ unsigned cvt_pk_bf16(float lo, float hi) { unsigned r; asm volatile("v_cvt_pk_bf16_f32 %0, %1, %2" : "=v"(r) : "v"(lo), "v"(hi)); return r; }
typedef float f32x2 __attribute__((ext_vector_type(2)));
template <class Epi, class Sched, bool ALIGN_EPI = false, bool SP2 = false>
__device__ __forceinline__ void gemm_phase(PG8_LAS unsigned char* lds, const Gemm g, const Sched& S, const Epi& E) {
    const int tid = opaque_tid(), wid = __builtin_amdgcn_readfirstlane(tid >> 6), lane = tid & 63, wr = wid >> 2, wc = wid & 3, fr = lane & 15, fq = lane >> 4;
    const int K = g.K, nt = K / BK;
    unsigned voffA[2], voffB[2];
#pragma unroll
    for (int i = 0; i < 2; ++i) { int R, C; stage_rc(tid * 16 + i * 8192, R, C); const int Rb = Epi::PERM ? ((R & ~31) + perm32(R & 31)) : R;
        voffA[i] = (unsigned)(R * K + C) * 2u; voffB[i] = (unsigned)(Rb * K + C) * 2u; }
    const size_t kstep = (size_t)(BK * 2);
    const size_t hstep = (size_t)HALF * K * 2;
    const size_t tstep = 2 * hstep;
    const unsigned ldsw = (unsigned)wid * 1024u;
    const int aoff = lds_byte(wr * 64 + fr, fq * 8), boff = lds_byte(wc * 32 + fr, fq * 8);
#define PG8_SA(b, h) (((b) * 2 + (h)) * HTB)
#define PG8_SB(b, h) ((4 + (b) * 2 + (h)) * HTB)
#define PG8_STAGE(bufoff, gbase, voff) do { _Pragma("unroll") for (int _i = 0; _i < 2; ++_i) \
        __builtin_amdgcn_global_load_lds((const unsigned*)((const char*)(gbase) + (voff)[_i]), (PG8_LAS unsigned*)(lds + (bufoff) + ldsw + _i * 8192), 16, 0, 0); } while (0)
#define PG8_LDA(dst, b, h) do { _Pragma("unroll") for (int m = 0; m < 4; ++m) _Pragma("unroll") for (int k = 0; k < 2; ++k) dst[m][k] = *(const PG8_LAS bf16x8*)(lds + PG8_SA(b, h) + aoff + m * 2048 + k * 1024); } while (0)
#define PG8_LDB(dst, b, h) do { _Pragma("unroll") for (int n = 0; n < 2; ++n) _Pragma("unroll") for (int k = 0; k < 2; ++k) dst[n][k] = *(const PG8_LAS bf16x8*)(lds + PG8_SB(b, h) + boff + n * 2048 + k * 1024); } while (0)
#define PG8_MMA(ai, bj, At, Bt) do { __builtin_amdgcn_s_setprio(1); _Pragma("unroll") for (int m = 0; m < 4; ++m) _Pragma("unroll") for (int n = 0; n < 2; ++n) _Pragma("unroll") for (int k = 0; k < 2; ++k) \
        acc[ai][bj][m][n] = __builtin_amdgcn_mfma_f32_16x16x32_bf16(Bt[n][k], At[m][k], acc[ai][bj][m][n], 0, 0, 0); __builtin_amdgcn_s_setprio(0); } while (0)
#define PG8_WAIT_V(n) asm volatile("s_waitcnt vmcnt(" #n ")" ::: "memory")
#define PG8_WAIT_L(n) asm volatile("s_waitcnt lgkmcnt(" #n ")" ::: "memory")
#define PG8_BAR __builtin_amdgcn_s_barrier()
#define PG8_SCHED __builtin_amdgcn_sched_barrier(0)
    Unit cur, nxt; int ui = 0;
    if (!S.next(0, cur)) return;
    f32x4 acc[2][2][4][2];
#pragma unroll
    for (int a = 0; a < 2; ++a)
#pragma unroll
        for (int b = 0; b < 2; ++b)
#pragma unroll
            for (int m = 0; m < 4; ++m)
#pragma unroll
                for (int n = 0; n < 2; ++n) acc[a][b][m][n] = (f32x4){0.f, 0.f, 0.f, 0.f};
    bf16x8 At[4][2], B0[2][2], B1[2][2];
    const char* cA = (const char*)g.A + (size_t)cur.pm * tstep; const char* cB = (const char*)g.Bt + (size_t)cur.pn * tstep;
    S.a_ready(cur);
    if constexpr (SP2) {
        PG8_STAGE(PG8_SB(0, 0), cB, voffB); PG8_STAGE(PG8_SB(0, 1), cB + hstep, voffB); PG8_STAGE(PG8_SA(0, 0), cA, voffA); PG8_STAGE(PG8_SA(0, 1), cA + hstep, voffA);
        if (wr == 1) PG8_BAR;
        PG8_WAIT_V(2); PG8_BAR;
        PG8_STAGE(PG8_SB(1, 0), cB + kstep, voffB); PG8_STAGE(PG8_SA(1, 0), cA + kstep, voffA); PG8_STAGE(PG8_SB(1, 1), cB + hstep + kstep, voffB);
        PG8_WAIT_V(6); PG8_BAR;
    } else {
        PG8_STAGE(PG8_SB(0, 0), cB, voffB); PG8_STAGE(PG8_SA(0, 0), cA, voffA); PG8_STAGE(PG8_SB(0, 1), cB + hstep, voffB); PG8_STAGE(PG8_SA(0, 1), cA + hstep, voffA);
        if (wr == 1) PG8_BAR;
        PG8_WAIT_V(4); PG8_BAR;
        PG8_STAGE(PG8_SB(1, 0), cB + kstep, voffB); PG8_STAGE(PG8_SA(1, 0), cA + kstep, voffA); PG8_STAGE(PG8_SB(1, 1), cB + hstep + kstep, voffB);
        PG8_WAIT_V(6); PG8_BAR;
    }
    for (;;) {
        const bool has_next = S.next(ui + 1, nxt);
        const char* nA = has_next ? (const char*)g.A + (size_t)nxt.pm * tstep : cA; const char* nB = has_next ? (const char*)g.Bt + (size_t)nxt.pn * tstep : cB;
        for (int t = 0; t < nt; t += 2) {
            const bool last = (t == nt - 2);
            const char* a1 = cA + (size_t)(t + 1) * kstep;
            const char* a2 = last ? nA : cA + (size_t)(t + 2) * kstep; const char* b2 = last ? nB : cB + (size_t)(t + 2) * kstep;
            const char* a3 = a2 + kstep; const char* b3 = b2 + kstep;
            if (last && has_next) S.a_ready(nxt);
            if constexpr (SP2) {
            PG8_LDB(B0, 0, 0); PG8_LDB(B1, 0, 1); PG8_SCHED; PG8_LDA(At, 0, 0); PG8_STAGE(PG8_SA(1, 1), a1 + hstep, voffA);
            PG8_WAIT_V(8); PG8_WAIT_L(0); PG8_BAR; PG8_MMA(0, 0, At, B0); PG8_MMA(0, 1, At, B1); PG8_BAR; PG8_SCHED;
            PG8_LDA(At, 0, 1); PG8_STAGE(PG8_SB(0, 0), b2, voffB); PG8_STAGE(PG8_SB(0, 1), b2 + hstep, voffB); PG8_STAGE(PG8_SA(0, 0), a2, voffA);
            PG8_WAIT_V(8); PG8_WAIT_L(0); PG8_BAR; PG8_MMA(1, 0, At, B0); PG8_MMA(1, 1, At, B1); PG8_BAR; PG8_SCHED;
            PG8_LDB(B0, 1, 0); PG8_LDB(B1, 1, 1); PG8_SCHED; PG8_LDA(At, 1, 0); PG8_STAGE(PG8_SA(0, 1), a2 + hstep, voffA);
            PG8_WAIT_V(8); PG8_WAIT_L(0); PG8_BAR; PG8_MMA(0, 0, At, B0); PG8_MMA(0, 1, At, B1); PG8_BAR; PG8_SCHED;
            PG8_LDA(At, 1, 1); PG8_STAGE(PG8_SB(1, 0), b3, voffB); PG8_STAGE(PG8_SB(1, 1), b3 + hstep, voffB); PG8_STAGE(PG8_SA(1, 0), a3, voffA);
            PG8_WAIT_V(8); PG8_WAIT_L(0); PG8_BAR; PG8_MMA(1, 0, At, B0); PG8_MMA(1, 1, At, B1); PG8_BAR; PG8_SCHED;
            } else {
            PG8_LDB(B0, 0, 0); PG8_SCHED; PG8_LDA(At, 0, 0); PG8_STAGE(PG8_SA(1, 1), a1 + hstep, voffA);
            PG8_WAIT_L(8); PG8_BAR; PG8_WAIT_L(0); PG8_MMA(0, 0, At, B0); PG8_BAR; PG8_SCHED;
            PG8_LDB(B1, 0, 1); PG8_STAGE(PG8_SB(0, 0), b2, voffB);
            PG8_BAR; PG8_WAIT_L(0); PG8_MMA(0, 1, At, B1); PG8_BAR;
            PG8_LDA(At, 0, 1); PG8_STAGE(PG8_SA(0, 0), a2, voffA);
            PG8_BAR; PG8_WAIT_L(0); PG8_MMA(1, 0, At, B0); PG8_BAR; PG8_SCHED;
            PG8_STAGE(PG8_SB(0, 1), b2 + hstep, voffB);
            PG8_WAIT_V(6); PG8_BAR; PG8_MMA(1, 1, At, B1); PG8_BAR;
            PG8_LDB(B0, 1, 0); PG8_SCHED; PG8_LDA(At, 1, 0); PG8_STAGE(PG8_SA(0, 1), a2 + hstep, voffA);
            PG8_WAIT_L(8); PG8_BAR; PG8_WAIT_L(0); PG8_MMA(0, 0, At, B0); PG8_BAR; PG8_SCHED;
            PG8_LDB(B1, 1, 1); PG8_STAGE(PG8_SB(1, 0), b3, voffB);
            PG8_BAR; PG8_WAIT_L(0); PG8_MMA(0, 1, At, B1); PG8_BAR;
            PG8_LDA(At, 1, 1); PG8_STAGE(PG8_SA(1, 0), a3, voffA);
            PG8_BAR; PG8_WAIT_L(0); PG8_MMA(1, 0, At, B0); PG8_BAR; PG8_SCHED;
            PG8_STAGE(PG8_SB(1, 1), b3 + hstep, voffB);
            PG8_WAIT_V(6); PG8_BAR; PG8_MMA(1, 1, At, B1); PG8_BAR;
            }
        }
        if constexpr (ALIGN_EPI) { if (wr == 0) PG8_BAR; }
        if constexpr (!Epi::AFTER_DRAIN) { E(acc, cur, wr, wc, fr, fq); S.done(cur); }
        if (!has_next) break;
#pragma unroll
        for (int a = 0; a < 2; ++a)
#pragma unroll
            for (int b = 0; b < 2; ++b)
#pragma unroll
                for (int m = 0; m < 4; ++m)
#pragma unroll
                    for (int n = 0; n < 2; ++n) acc[a][b][m][n] = (f32x4){0.f, 0.f, 0.f, 0.f};
        cur = nxt; cA = nA; cB = nB; ++ui;
        if constexpr (ALIGN_EPI) { if (wr == 1) PG8_BAR; }
    }
    PG8_WAIT_V(0);
    if constexpr (!ALIGN_EPI) { if (wr == 0) PG8_BAR; }
    PG8_BAR;
    if constexpr (Epi::AFTER_DRAIN) { E.fused(acc, cur, wr, wc, fr, fq, lds, wid, lane); S.done(cur); }
#undef PG8_SA
#undef PG8_SB
#undef PG8_STAGE
#undef PG8_LDA
#undef PG8_LDB
#undef PG8_MMA
#undef PG8_WAIT_V
#undef PG8_WAIT_L
#undef PG8_BAR
#undef PG8_SCHED
}
}

#define LAS __attribute__((address_space(3)))
typedef unsigned short bf16_t;
typedef short bf16x8 __attribute__((ext_vector_type(8)));
typedef float f32x4 __attribute__((ext_vector_type(4)));
typedef float f32x16 __attribute__((ext_vector_type(16)));
typedef unsigned u32x4 __attribute__((ext_vector_type(4)));
typedef unsigned u32x2 __attribute__((ext_vector_type(2)));
typedef float f32x2_t __attribute__((ext_vector_type(2)));
typedef __bf16 bf16x2_t __attribute__((ext_vector_type(2)));

constexpr int DM = 1024, NBATCH = 4, SEQ = 4096, NMETA = 16, TP = SEQ + NMETA;
constexpr int DB = 8, DS = 32, PAST = 4096;
constexpr int RP = NBATCH * TP;
constexpr int RS = DB * DS;
constexpr int R1 = RP + RS;
constexpr int M1 = 16896;
constexpr int RC = NBATCH * SEQ;
constexpr int M2 = RC + RS;
constexpr int NIN = 6656, DFF = 4096;
constexpr float EPS = 1e-6f;
constexpr float QSCALE = 0.18033688011112042f;
constexpr float LAM_INIT = 0.2f;

constexpr size_t O_Y = 0, O_YS = 16777216, O_PDK = 17039360, O_PDV = 33882112, O_PSK = 50724864, O_PSV = 59146240,
                 O_SDK = 67567616, O_SDV = 67829760, O_SSK = 68091904, O_SSV = 68222976;

constexpr size_t MiB = 1u << 20;
constexpr size_t WS_WIN = 0, WS_WDO = 14 * MiB, WS_WSO = 16 * MiB, WS_WOUT = 17 * MiB, WS_W1 = 19 * MiB, WS_W2 = 27 * MiB;
constexpr size_t WS_ROPE = 35 * MiB, WS_SS = 36 * MiB, WS_BAR = 36 * MiB + 1536 * 1024, WS_PART = 38 * MiB;
constexpr size_t WS_XN = 50 * MiB;
constexpr size_t WS_QD = 83 * MiB, WS_KD = 116 * MiB, WS_VD = 149 * MiB;
constexpr size_t WS_QS = 182 * MiB, WS_KS = 199 * MiB, WS_VS = 216 * MiB;
constexpr size_t WS_T1 = 83 * MiB;
constexpr size_t WS_H = 83 * MiB;
constexpr size_t WS_G = 233 * MiB;
constexpr size_t WS_OD = 298 * MiB;
constexpr size_t WS_OS = 331 * MiB;
constexpr size_t WS_END = 348 * MiB;
constexpr int PART_FLOATS = 10400;

constexpr int LDS_BYTES = 147456;
#ifndef REP_P0
#define REP_P0 1
#endif
#ifndef REP_P1
#define REP_P1 1
#endif
#ifndef REP_P4
#define REP_P4 1
#endif
#ifndef REP_P5
#define REP_P5 1
#endif
#ifndef REP_P6
#define REP_P6 1
#endif
#ifndef REP_SYNC
#define REP_SYNC 0
#endif
#ifndef REP_DIFF
#define REP_DIFF 1
#endif
#ifndef REP_SB
#define REP_SB 1
#endif
#ifndef REP_P3
#define REP_P3 1
#endif
#ifndef REP_P2A
#define REP_P2A 1
#endif
#ifndef REP_P2B
#define REP_P2B 1
#endif

__device__ __forceinline__ unsigned cvtpk(float lo, float hi) { f32x2_t v = {lo, hi}; bf16x2_t b = __builtin_convertvector(v, bf16x2_t); return __builtin_bit_cast(unsigned, b); }
__device__ __forceinline__ float bf_lo(unsigned u) { return __uint_as_float(u << 16); }
__device__ __forceinline__ float bf_hi(unsigned u) { return __uint_as_float(u & 0xffff0000u); }
__device__ __forceinline__ int crow(int r, int hi) { return (r & 3) + 8 * (r >> 2) + 4 * hi; }
__device__ __forceinline__ float ex2(float x) { return __builtin_amdgcn_exp2f(x); }
__device__ __forceinline__ float lg2(float x) { return __builtin_amdgcn_logf(x); }
__device__ __forceinline__ float wave_sum(float v) {
#pragma unroll
    for (int o = 1; o < 64; o <<= 1) v += __shfl_xor(v, o);
    return v;
}
__device__ __forceinline__ u32x4 pack8(const float* v) { u32x4 w; w.x = cvtpk(v[0], v[1]); w.y = cvtpk(v[2], v[3]); w.z = cvtpk(v[4], v[5]); w.w = cvtpk(v[6], v[7]); return w; }

struct Args { const float* in[22]; float* out; unsigned char* ws; };
typedef const __attribute__((address_space(4))) Args* KArgs;
enum { I_XP = 0, I_XS, I_CDK, I_CDV, I_CSK, I_CSV, I_META, I_GMIX, I_WIN, I_QG, I_KG, I_LQ1, I_LK1, I_LQ2, I_LK2, I_SUBG, I_WDO, I_WSO, I_WOUT, I_GFFN, I_W1, I_W2 };

struct EpiIn {
    static constexpr bool PERM = true, AFTER_DRAIN = false;
    float* out; unsigned char* ws; const float* qg; const float* kg;
    __device__ __forceinline__ void operator()(const f32x4 (&acc)[2][2][4][2], const pg8::Unit& u, int wr, int wc, int fr, int fq) const {
        const int pn = u.pn;
        int type, cb;
        if (pn < 4) { type = 0; cb = 0; } else if (pn < 8) { type = 1; cb = 1024; } else if (pn < 12) { type = 2; cb = 2048; }
        else if (pn < 14) { type = 3; cb = 3072; } else if (pn < 16) { type = 4; cb = 3584; } else if (pn < 18) { type = 5; cb = 4096; } else { type = 6; cb = 4608; }
        const int col0 = pn * 256 + wc * 64 + fq * 8 - cb;
        const float* rope = (const float*)(ws + WS_ROPE);
        float gv[2][8];
        if (type <= 1) { const float* g = (type == 0) ? qg : kg;
#pragma unroll
            for (int bj = 0; bj < 2; ++bj)
#pragma unroll
                for (int i = 0; i < 8; ++i) gv[bj][i] = g[32 * bj + 8 * fq + i]; }
        bf16_t* bdst; int bld; size_t op, os; int ow;
        switch (type) {
            case 0: bdst = (bf16_t*)(ws + WS_QD); bld = 1024; op = 0; os = 0; ow = 0; break;
            case 1: bdst = (bf16_t*)(ws + WS_KD); bld = 1024; op = O_PDK; os = O_SDK; ow = 1024; break;
            case 2: bdst = (bf16_t*)(ws + WS_VD); bld = 1024; op = O_PDV; os = O_SDV; ow = 1024; break;
            case 3: bdst = (bf16_t*)(ws + WS_QS); bld = 512; op = 0; os = 0; ow = 0; break;
            case 4: bdst = (bf16_t*)(ws + WS_KS); bld = 512; op = O_PSK; os = O_SSK; ow = 512; break;
            case 5: bdst = (bf16_t*)(ws + WS_VS); bld = 512; op = O_PSV; os = O_SSV; ow = 512; break;
            default: bdst = (bf16_t*)(ws + WS_G); bld = 2048; op = 0; os = 0; ow = 0; break;
        }
#pragma unroll
        for (int ai = 0; ai < 2; ++ai)
#pragma unroll
            for (int m = 0; m < 4; ++m) {
                const int row = u.pm * 256 + ai * 128 + wr * 64 + m * 16 + fr;
                const bool valid = row < R1;
                const bool samp = row >= RP;
                int pos, crw;
                if (!samp) { const int b = row / TP; const int t = row - b * TP; pos = t; crw = (t >= NMETA) ? b * SEQ + t - NMETA : -1; }
                else { const int r = row - RP; pos = valid ? PAST + (r & 31) : 0; crw = RC + r; }
                float v[2][8];
#pragma unroll
                for (int bj = 0; bj < 2; ++bj)
#pragma unroll
                    for (int n = 0; n < 2; ++n)
#pragma unroll
                        for (int e = 0; e < 4; ++e) v[bj][4 * n + e] = acc[ai][bj][m][n][e];
                if (type <= 1) {
                    float ss = 0.f;
#pragma unroll
                    for (int bj = 0; bj < 2; ++bj)
#pragma unroll
                        for (int i = 0; i < 8; ++i) ss += v[bj][i] * v[bj][i];
                    ss += __shfl_xor(ss, 16); ss += __shfl_xor(ss, 32);
                    const float rstd = rsqrtf(ss * (1.0f / 64.0f) + EPS);
#pragma unroll
                    for (int bj = 0; bj < 2; ++bj)
#pragma unroll
                        for (int i = 0; i < 8; ++i) v[bj][i] *= rstd * gv[bj][i];
                    float pv[8];
#pragma unroll
                    for (int i = 0; i < 8; ++i) pv[i] = __shfl_xor(v[0][i], 16);
                    if (fq < 2) { const float* rp = rope + pos * 16;
#pragma unroll
                        for (int i = 0; i < 8; ++i) { const float c = rp[i], s = rp[8 + i]; v[0][i] = (fq == 0) ? (v[0][i] * c - pv[i] * s) : (v[0][i] * c + pv[i] * s); } }
                }
                if (type == 0 || type == 3) {
#pragma unroll
                    for (int bj = 0; bj < 2; ++bj)
#pragma unroll
                        for (int i = 0; i < 8; ++i) v[bj][i] *= QSCALE;
                }
                if (type == 6) {
#pragma unroll
                    for (int bj = 0; bj < 2; ++bj)
#pragma unroll
                        for (int i = 0; i < 8; ++i) v[bj][i] = __builtin_amdgcn_rcpf(1.0f + __expf(-v[bj][i]));
                }
                const int brow = (type == 6) ? crw : row;
                if (valid && brow >= 0) {
#pragma unroll
                    for (int bj = 0; bj < 2; ++bj) {
                        const int c = col0 + 32 * bj;
                        *(u32x4*)(bdst + (size_t)brow * bld + c) = pack8(v[bj]);
                        if (ow) { float* o = samp ? out + os + (size_t)(row - RP) * ow + c : out + op + (size_t)row * ow + c;
                            __builtin_nontemporal_store((f32x4){v[bj][0], v[bj][1], v[bj][2], v[bj][3]}, (f32x4*)o); __builtin_nontemporal_store((f32x4){v[bj][4], v[bj][5], v[bj][6], v[bj][7]}, (f32x4*)(o + 4)); }
                    }
                }
            }
    }
};

struct EpiGateA {
    static constexpr bool PERM = true, AFTER_DRAIN = false;
    const bf16_t* G; float* T1;
    __device__ __forceinline__ void operator()(const f32x4 (&acc)[2][2][4][2], const pg8::Unit& u, int wr, int wc, int fr, int fq) const {
        const int row0 = u.pm * 256 + wr * 64 + fr, c0 = u.pn * 256 + wc * 64 + fq * 8;
        u32x4 g[2][4][2];
#pragma unroll
        for (int ai = 0; ai < 2; ++ai)
#pragma unroll
            for (int m = 0; m < 4; ++m)
#pragma unroll
                for (int bj = 0; bj < 2; ++bj) g[ai][m][bj] = *(const u32x4*)(G + (size_t)(row0 + ai * 128 + m * 16) * 2048 + c0 + bj * 32);
#pragma unroll
        for (int ai = 0; ai < 2; ++ai)
#pragma unroll
            for (int m = 0; m < 4; ++m)
#pragma unroll
                for (int bj = 0; bj < 2; ++bj) { const u32x4 gg = g[ai][m][bj];
                    const f32x4 a0 = acc[ai][bj][m][0], a1 = acc[ai][bj][m][1];
                    bf16_t* t = (bf16_t*)T1 + (size_t)(row0 + ai * 128 + m * 16) * 1024 + c0 + bj * 32;
                    float v[8] = {bf_lo(gg.x) * a0[0], bf_hi(gg.x) * a0[1], bf_lo(gg.y) * a0[2], bf_hi(gg.y) * a0[3], bf_lo(gg.z) * a1[0], bf_hi(gg.z) * a1[1], bf_lo(gg.w) * a1[2], bf_hi(gg.w) * a1[3]};
                    *(u32x4*)t = pack8(v); }
    }
};
struct EpiGateB {
    static constexpr bool PERM = true, AFTER_DRAIN = false;
    const bf16_t* G; const float* T1; bf16_t* MG;
    __device__ __forceinline__ void operator()(const f32x4 (&acc)[2][2][4][2], const pg8::Unit& u, int wr, int wc, int fr, int fq) const {
        const int row0 = u.pm * 256 + wr * 64 + fr, c0 = u.pn * 256 + wc * 64 + fq * 8;
#pragma unroll
        for (int ai = 0; ai < 2; ++ai)
#pragma unroll
            for (int mh = 0; mh < 2; ++mh) {
                u32x4 g[2][2], tb[2][2];
#pragma unroll
                for (int mm = 0; mm < 2; ++mm)
#pragma unroll
                    for (int bj = 0; bj < 2; ++bj) { const size_t r = (size_t)(row0 + ai * 128 + (2 * mh + mm) * 16); const int c = c0 + bj * 32;
                        g[mm][bj] = *(const u32x4*)(G + r * 2048 + 1024 + c); tb[mm][bj] = *(const u32x4*)((const bf16_t*)T1 + r * 1024 + c); }
#pragma unroll
                for (int mm = 0; mm < 2; ++mm)
#pragma unroll
                    for (int bj = 0; bj < 2; ++bj) { const int m = 2 * mh + mm; const size_t r = (size_t)(row0 + ai * 128 + m * 16); const int c = c0 + bj * 32;
                        const u32x4 gg = g[mm][bj]; const f32x4 a0 = acc[ai][bj][m][0], a1 = acc[ai][bj][m][1]; const u32x4 tt = tb[mm][bj];
                        const f32x4 x0 = {bf_lo(tt.x), bf_hi(tt.x), bf_lo(tt.y), bf_hi(tt.y)}, x1 = {bf_lo(tt.z), bf_hi(tt.z), bf_lo(tt.w), bf_hi(tt.w)};
                        float v[8] = {x0[0] + bf_lo(gg.x) * a0[0], x0[1] + bf_hi(gg.x) * a0[1], x0[2] + bf_lo(gg.y) * a0[2], x0[3] + bf_hi(gg.y) * a0[3],
                                      x1[0] + bf_lo(gg.z) * a1[0], x1[1] + bf_hi(gg.z) * a1[1], x1[2] + bf_lo(gg.w) * a1[2], x1[3] + bf_hi(gg.w) * a1[3]};
                        *(u32x4*)(MG + r * 1024 + c) = pack8(v); }
            }
    }
};
struct EpiOut {
    static constexpr bool PERM = true, AFTER_DRAIN = false;
    const float* xp; const float* xs; float* X1; bf16_t* X1b; float* SS;
    __device__ __forceinline__ void operator()(const f32x4 (&acc)[2][2][4][2], const pg8::Unit& u, int wr, int wc, int fr, int fq) const {
        const int row0 = u.pm * 256 + wr * 64 + fr, c0 = u.pn * 256 + wc * 64 + fq * 8;
#pragma unroll
        for (int ai = 0; ai < 2; ++ai) {
            f32x4 xv[4][2][2];
#pragma unroll
            for (int m = 0; m < 4; ++m) { const int row = row0 + ai * 128 + m * 16;
                const float* xr = (row < RC) ? xp + (size_t)row * 1024 : xs + (size_t)(row - RC) * 1024;
#pragma unroll
                for (int bj = 0; bj < 2; ++bj) { xv[m][bj][0] = __builtin_nontemporal_load((const f32x4*)(xr + c0 + bj * 32)); xv[m][bj][1] = __builtin_nontemporal_load((const f32x4*)(xr + c0 + bj * 32 + 4)); } }
#pragma unroll
            for (int m = 0; m < 4; ++m) { const int row = row0 + ai * 128 + m * 16;
                float ss = 0.f;
#pragma unroll
                for (int bj = 0; bj < 2; ++bj) { const int c = c0 + bj * 32;
                    const f32x4 a0 = acc[ai][bj][m][0] + xv[m][bj][0], a1 = acc[ai][bj][m][1] + xv[m][bj][1];
                    *(f32x4*)(X1 + (size_t)row * 1024 + c) = a0; *(f32x4*)(X1 + (size_t)row * 1024 + c + 4) = a1;
                    float v[8] = {a0[0], a0[1], a0[2], a0[3], a1[0], a1[1], a1[2], a1[3]};
                    *(u32x4*)(X1b + (size_t)row * 1024 + c) = pack8(v);
#pragma unroll
                    for (int i = 0; i < 8; ++i) ss += v[i] * v[i]; }
                ss += __shfl_xor(ss, 16); ss += __shfl_xor(ss, 32);
                if (fq == 0) SS[(size_t)row * 16 + u.pn * 4 + wc] = ss; }
        }
    }
};
struct EpiFF1 {
    static constexpr bool PERM = true, AFTER_DRAIN = false;
    const float* SS; bf16_t* H;
    __device__ __forceinline__ void operator()(const f32x4 (&acc)[2][2][4][2], const pg8::Unit& u, int wr, int wc, int fr, int fq) const {
        const int row0 = u.pm * 256 + wr * 64 + fr, c0 = u.pn * 256 + wc * 64 + fq * 8;
#pragma unroll
        for (int ai = 0; ai < 2; ++ai) {
            f32x4 sv[4][4];
#pragma unroll
            for (int m = 0; m < 4; ++m) { const f32x4* sp = (const f32x4*)(SS + (size_t)(row0 + ai * 128 + m * 16) * 16);
#pragma unroll
                for (int i = 0; i < 4; ++i) sv[m][i] = sp[i]; }
#pragma unroll
            for (int m = 0; m < 4; ++m) { const int row = row0 + ai * 128 + m * 16;
                const f32x4 s0 = sv[m][0], s1 = sv[m][1], s2 = sv[m][2], s3 = sv[m][3];
                const float s = ((s0[0] + s0[1]) + (s0[2] + s0[3])) + ((s1[0] + s1[1]) + (s1[2] + s1[3])) + ((s2[0] + s2[1]) + (s2[2] + s2[3])) + ((s3[0] + s3[1]) + (s3[2] + s3[3]));
                const float r2 = 1.0f / (s * (1.0f / 1024.0f) + EPS);
#pragma unroll
                for (int bj = 0; bj < 2; ++bj) { float v[8];
#pragma unroll
                    for (int n = 0; n < 2; ++n)
#pragma unroll
                        for (int e = 0; e < 4; ++e) { const float a = fmaxf(acc[ai][bj][m][n][e], 0.f); v[4 * n + e] = a * a * r2; }
                    *(u32x4*)(H + (size_t)row * 4096 + c0 + bj * 32) = pack8(v); } }
        }
    }
};
struct EpiFF2 {
    static constexpr bool PERM = true, AFTER_DRAIN = false;
    const float* X1; float* out;
    __device__ __forceinline__ void operator()(const f32x4 (&acc)[2][2][4][2], const pg8::Unit& u, int wr, int wc, int fr, int fq) const {
        const int row0 = u.pm * 256 + wr * 64 + fr, c0 = u.pn * 256 + wc * 64 + fq * 8;
#pragma unroll
        for (int ai = 0; ai < 2; ++ai) {
            f32x4 xv[4][2][2];
#pragma unroll
            for (int m = 0; m < 4; ++m) { const float* xr = X1 + (size_t)(row0 + ai * 128 + m * 16) * 1024 + c0;
#pragma unroll
                for (int bj = 0; bj < 2; ++bj) { xv[m][bj][0] = *(const f32x4*)(xr + bj * 32); xv[m][bj][1] = *(const f32x4*)(xr + bj * 32 + 4); } }
#pragma unroll
            for (int m = 0; m < 4; ++m) { const int row = row0 + ai * 128 + m * 16;
                float* dst = (row < RC) ? out + O_Y + (size_t)row * 1024 : out + O_YS + (size_t)(row - RC) * 1024;
#pragma unroll
                for (int bj = 0; bj < 2; ++bj) { const int c = c0 + bj * 32;
                    __builtin_nontemporal_store(acc[ai][bj][m][0] + xv[m][bj][0], (f32x4*)(dst + c)); __builtin_nontemporal_store(acc[ai][bj][m][1] + xv[m][bj][1], (f32x4*)(dst + c + 4)); } }
        }
    }
};

__device__ __forceinline__ void p0_transpose_item(const float* W, int K, int N, bf16_t* WT, const float* gk, LAS float* scr, int item, int lane, int kmask = 0x7fffffff, float gscale = 1.0f) {
    const int nblk = N / 32, kb = item / nblk, nb = item % nblk, k0 = 64 * kb, n0 = 32 * nb;
    { f32x4 v[8];
#pragma unroll
      for (int i = 0; i < 8; ++i) v[i] = __builtin_nontemporal_load((const f32x4*)(W + (size_t)(k0 + 8 * i + (lane >> 3)) * N + n0 + 4 * (lane & 7)));
#pragma unroll
      for (int i = 0; i < 8; ++i) { const int kk = 8 * i + (lane >> 3); const float g = gk ? gk[(k0 + kk) & kmask] * gscale : 1.0f;
#pragma unroll
          for (int j = 0; j < 4; ++j) scr[kk * 33 + 4 * (lane & 7) + j] = v[i][j] * g; } }
    asm volatile("s_waitcnt lgkmcnt(0)" ::: "memory");
    const int q = (n0 & 255) >> 5; const int n0p = (n0 & ~255) + 32 * (4 * (q & 1) + (q >> 1));
    const int c = lane & 7;
#pragma unroll
    for (int j = 0; j < 4; ++j) { const int n = (lane >> 3) + 8 * j; const LAS float* s = scr + (8 * c) * 33 + n;
        u32x4 o; o.x = cvtpk(s[0 * 33], s[1 * 33]); o.y = cvtpk(s[2 * 33], s[3 * 33]); o.z = cvtpk(s[4 * 33], s[5 * 33]); o.w = cvtpk(s[6 * 33], s[7 * 33]);
        *(u32x4*)(WT + (size_t)(n0p + n) * K + k0 + 8 * c) = o; }
    asm volatile("s_waitcnt lgkmcnt(0)" ::: "memory");
}

__device__ __forceinline__ void prologue(KArgs a, LAS unsigned char* lds, int vcu, int G) {
    const int tid = opaque_tid(), lane = tid & 63, wave = tid >> 6;
    unsigned char* ws = a->ws;
    LAS float* scr = (LAS float*)(lds + wave * 16384);
    const int gw = vcu * 8 + wave, NGW = G * 8;
    constexpr int I_IN = 16 * 208;
    for (int it = gw; it < I_IN; it += NGW) p0_transpose_item(a->in[I_WIN], 1024, NIN, (bf16_t*)(ws + WS_WIN), nullptr, scr, it, lane);
    const f32x4* gm = (const f32x4*)a->in[I_GMIX] + lane;
    bf16_t* XN = (bf16_t*)(ws + WS_XN);
    for (int row = gw; row < M1; row += NGW) {
        unsigned long long* o8 = (unsigned long long*)(XN + (size_t)row * 1024) + lane;
        if (row >= R1) {
#pragma unroll
            for (int j = 0; j < 4; ++j) o8[64 * j] = 0ull;
            continue; }
        const float* src;
        if (row < RP) { const int b = row / TP, t = row - b * TP; src = (t < NMETA) ? a->in[I_META] + (size_t)t * 1024 : a->in[I_XP] + ((size_t)b * SEQ + (t - NMETA)) * 1024; }
        else src = a->in[I_XS] + (size_t)(row - RP) * 1024;
        const f32x4* xr = (const f32x4*)src + lane;
        f32x4 v[4]; float s = 0.f;
#pragma unroll
        for (int j = 0; j < 4; ++j) { v[j] = __builtin_nontemporal_load(xr + 64 * j); s += (v[j][0] * v[j][0] + v[j][1] * v[j][1]) + (v[j][2] * v[j][2] + v[j][3] * v[j][3]); }
        const float rstd = rsqrtf(wave_sum(s) * (1.0f / 1024.0f) + EPS);
#pragma unroll
        for (int j = 0; j < 4; ++j) { const f32x4 g = gm[64 * j]; const f32x4 y = v[j] * rstd * g;
            o8[64 * j] = (unsigned long long)cvtpk(y[0], y[1]) | ((unsigned long long)cvtpk(y[2], y[3]) << 32); }
    }
    float* rope = (float*)(ws + WS_ROPE);
    for (int e = vcu * 512 + tid; e < (PAST + DS) * 8; e += G * 512) {
        const int pos = e >> 3, i = e & 7;
        const float inv = (i == 0) ? 1.0f : (i == 1) ? 0.1939227432012558f : (i == 2) ? 0.03760603070259094f : (i == 3) ? 0.007292664609849453f :
                          (i == 4) ? 0.0014142135623842478f : (i == 5) ? 0.00027424818836152554f : (i == 6) ? 5.318296098266728e-05f : 1.0313386155758053e-05f;
        const float ang = (float)pos * inv;
        double rev = (double)ang * 0.15915494309189535; rev -= floor(rev);
        const float rf = (float)rev;
        rope[pos * 16 + i] = __builtin_amdgcn_cosf(rf); rope[pos * 16 + 8 + i] = __builtin_amdgcn_sinf(rf);
    }
}

__device__ __forceinline__ void convert_late_weights(KArgs a, LAS unsigned char* lds, int idx, int n) {
    const int tid = opaque_tid(), lane = tid & 63, wave = tid >> 6;
    unsigned char* ws = a->ws;
    LAS float* scr = (LAS float*)(lds + wave * 16384);
    constexpr int I_DO = 16 * 32, I_SO = 8 * 32, I_OUT = 16 * 32, I_F1 = 16 * 128, I_F2 = 64 * 32;
    constexpr int NITEMS = I_DO + I_SO + I_OUT + I_F1 + I_F2;
    for (int it = idx * 8 + wave; it < NITEMS; it += n * 8) {
        int r = it;
        if (r < I_DO) { p0_transpose_item(a->in[I_WDO], 1024, 1024, (bf16_t*)(ws + WS_WDO), a->in[I_SUBG], scr, r, lane, 127, 1.0f - LAM_INIT); continue; } r -= I_DO;
        if (r < I_SO) { p0_transpose_item(a->in[I_WSO], 512, 1024, (bf16_t*)(ws + WS_WSO), nullptr, scr, r, lane); continue; } r -= I_SO;
        if (r < I_OUT) { p0_transpose_item(a->in[I_WOUT], 1024, 1024, (bf16_t*)(ws + WS_WOUT), nullptr, scr, r, lane); continue; } r -= I_OUT;
        if (r < I_F1) { p0_transpose_item(a->in[I_W1], 1024, DFF, (bf16_t*)(ws + WS_W1), a->in[I_GFFN], scr, r, lane); continue; } r -= I_F1;
        p0_transpose_item(a->in[I_W2], DFF, 1024, (bf16_t*)(ws + WS_W2), nullptr, scr, r, lane);
    }
}

constexpr int ATT_STAGE = 34816, ATT_VOFF = 17408, ATT_WSF = 2 * ATT_STAGE, ATT_QOFF = ATT_WSF + 2048;
#define MFMA32(a, b, c) __builtin_amdgcn_mfma_f32_32x32x16_bf16((a), (b), (c), 0, 0, 0)

__device__ __forceinline__ float rowmax32(const f32x16& p0, const f32x16& p1) {
    float a = fmaxf(p0[0], p1[0]);
#pragma unroll
    for (int r = 1; r < 16; ++r) a = fmaxf(a, fmaxf(p0[r], p1[r]));
    return fmaxf(a, __shfl_xor(a, 32));
}
__device__ __forceinline__ void packP(const f32x16& p0, const f32x16& p1, bf16x8 (&pa)[4]) {
    u32x4 w;
    w = (u32x4){cvtpk(p0[0], p0[1]), cvtpk(p0[2], p0[3]), cvtpk(p0[4], p0[5]), cvtpk(p0[6], p0[7])}; pa[0] = __builtin_bit_cast(bf16x8, w);
    w = (u32x4){cvtpk(p0[8], p0[9]), cvtpk(p0[10], p0[11]), cvtpk(p0[12], p0[13]), cvtpk(p0[14], p0[15])}; pa[1] = __builtin_bit_cast(bf16x8, w);
    w = (u32x4){cvtpk(p1[0], p1[1]), cvtpk(p1[2], p1[3]), cvtpk(p1[4], p1[5]), cvtpk(p1[6], p1[7])}; pa[2] = __builtin_bit_cast(bf16x8, w);
    w = (u32x4){cvtpk(p1[8], p1[9]), cvtpk(p1[10], p1[11]), cvtpk(p1[12], p1[13]), cvtpk(p1[14], p1[15])}; pa[3] = __builtin_bit_cast(bf16x8, w);
}

constexpr int D1_VOFF = 17408, D1_QOFF = 2 * ATT_STAGE + 2048;
__device__ __forceinline__ void diff_unit1(KArgs a, LAS unsigned char* lds, int b, int h, int qb, float lam) {
    const int tid = opaque_tid(), lane = tid & 63, r32 = lane & 31, hi = lane >> 5;
    const int wid = __builtin_amdgcn_readfirstlane(tid >> 6);
    unsigned char* ws = a->ws;
    const int rowb = b * TP;
    const int q0 = NMETA + 256 * qb + 32 * wid;
    const int jmax = 4 * qb + 4, jw = 4 * qb + (wid >> 1) + 1;
    const bf16_t* Kb = (const bf16_t*)(ws + WS_KD) + (size_t)rowb * 1024 + h * 128;
    const bf16_t* Vb = (const bf16_t*)(ws + WS_VD) + (size_t)rowb * 1024 + h * 128;
    LAS unsigned char* qlds = lds + D1_QOFF + wid * 8192 + lane * 16;
    { const bf16_t* Qp = (const bf16_t*)(ws + WS_QD) + (size_t)(rowb + q0 + r32) * 1024 + h * 128 + hi * 8;
#pragma unroll
      for (int s = 0; s < 2; ++s)
#pragma unroll
          for (int d0 = 0; d0 < 4; ++d0) *(LAS bf16x8*)(qlds + (s * 4 + d0) * 1024) = *(const bf16x8*)(Qp + s * 64 + d0 * 16); }
    f32x16 o[2][4];
#pragma unroll
    for (int s = 0; s < 2; ++s)
#pragma unroll
        for (int d0 = 0; d0 < 4; ++d0)
#pragma unroll
            for (int r = 0; r < 16; ++r) o[s][d0][r] = 0.f;
    float ls[2] = {0.f, 0.f};
    int never = 0; asm volatile("" : "+s"(never));
    LAS float* wsf = (LAS float*)(lds + ATT_WSF) + wid * 64;
    const int kkv = tid >> 4, kdc = tid & 15;
    const int vkp = tid & 31, vdc = tid >> 5;
    u32x4 kr[2], vr[2];
#define DA_GLOAD(j) do { \
        _Pragma("unroll") for (int i_ = 0; i_ < 2; ++i_) { int pos_ = 64 * (j) - 48 + kkv + 32 * i_; pos_ = pos_ < 0 ? 0 : pos_; kr[i_] = *(const u32x4*)(Kb + (size_t)pos_ * 1024 + kdc * 8); } \
        _Pragma("unroll") for (int i_ = 0; i_ < 2; ++i_) { int pos_ = 64 * (j) - 48 + 2 * vkp + i_; pos_ = pos_ < 0 ? 0 : pos_; vr[i_] = *(const u32x4*)(Vb + (size_t)pos_ * 1024 + vdc * 8); } } while (0)
#define DA_LSTORE(st_) do { LAS unsigned char* sb_ = lds + (st_) * ATT_STAGE; \
        _Pragma("unroll") for (int i_ = 0; i_ < 2; ++i_) *(LAS u32x4*)(sb_ + (kkv + 32 * i_) * 272 + kdc * 16) = kr[i_]; \
        _Pragma("unroll") for (int e_ = 0; e_ < 8; ++e_) { const unsigned lo_ = (vr[0][e_ >> 1] >> (16 * (e_ & 1))) & 0xffffu, hi_ = (vr[1][e_ >> 1] >> (16 * (e_ & 1))) & 0xffffu; \
            *(LAS unsigned*)(sb_ + D1_VOFF + (8 * vdc + e_) * 136 + vkp * 4) = lo_ | (hi_ << 16); } } while (0)
    DA_GLOAD(0); DA_LSTORE(0);
    __syncthreads();
    for (int j = 0; j <= jmax; ++j) {
        if (j < jmax) DA_GLOAD(j + 1);
        if (j <= jw) {
            const LAS unsigned char* Ks = lds + (j & 1) * ATT_STAGE + r32 * 272 + hi * 16;
            const LAS unsigned char* Vs = lds + (j & 1) * ATT_STAGE + D1_VOFF + r32 * 136 + hi * 8;
#pragma unroll
            for (int s = 0; s < 2; ++s) {
#pragma unroll
                for (int hf = 0; hf < 2; ++hf) {
                    if (j == 0 && hf == 0) continue;
                    f32x16 p;
#pragma unroll
                    for (int r = 0; r < 16; ++r) p[r] = 0.f;
#pragma unroll
                    for (int d0 = 0; d0 < 4; ++d0) {
                        const bf16x8 ka = *(const LAS bf16x8*)(Ks + hf * 32 * 272 + s * 128 + d0 * 32);
                        const bf16x8 qf = *(const LAS bf16x8*)(qlds + (s * 4 + d0) * 1024);
                        p = MFMA32(ka, qf, p); }
                    if (j == 0) {
#pragma unroll
                        for (int r = 0; r < 16; ++r) if (crow(r, hi) < 16) p[r] = -INFINITY; }
                    if (never) asm volatile("s_nop 0");
                    float sum = 0.f;
#pragma unroll
                    for (int r = 0; r < 16; ++r) { p[r] = ex2(p[r]); sum += p[r]; }
                    ls[s] += sum;
                    u32x4 w0 = {cvtpk(p[0], p[1]), cvtpk(p[2], p[3]), cvtpk(p[4], p[5]), cvtpk(p[6], p[7])}, w1 = {cvtpk(p[8], p[9]), cvtpk(p[10], p[11]), cvtpk(p[12], p[13]), cvtpk(p[14], p[15])};
                    const bf16x8 pa0 = __builtin_bit_cast(bf16x8, w0), pa1 = __builtin_bit_cast(bf16x8, w1);
                    {
                        const unsigned vb_ = (unsigned)(size_t)(Vs) + hf * 64;
                        const unsigned vb0 = vb_, vb1 = vb_ + 4352, vb2 = vb_ + 2 * 4352, vb3 = vb_ + 3 * 4352;
                        u32x4 fa, fb;
#define VRD(dst_, base_, k_) asm volatile("ds_read2_b64 %0, %1 offset0:%2 offset1:%3" : "=v"(dst_) : "v"(base_), "n"((k_) * 4), "n"((k_) * 4 + 2) : "memory")
#define VWT(n_, dst_) asm volatile("s_waitcnt lgkmcnt(" #n_ ")" : "+v"(dst_) :: "memory")
                        VRD(fa, vb0, 0); VRD(fb, vb0, 1);
                        VWT(1, fa); o[s][0] = MFMA32(pa0, __builtin_bit_cast(bf16x8, fa), o[s][0]); VRD(fa, vb1, 0);
                        VWT(1, fb); o[s][0] = MFMA32(pa1, __builtin_bit_cast(bf16x8, fb), o[s][0]); VRD(fb, vb1, 1);
                        VWT(1, fa); o[s][1] = MFMA32(pa0, __builtin_bit_cast(bf16x8, fa), o[s][1]); VRD(fa, vb2, 0);
                        VWT(1, fb); o[s][1] = MFMA32(pa1, __builtin_bit_cast(bf16x8, fb), o[s][1]); VRD(fb, vb2, 1);
                        VWT(1, fa); o[s][2] = MFMA32(pa0, __builtin_bit_cast(bf16x8, fa), o[s][2]); VRD(fa, vb3, 0);
                        VWT(1, fb); o[s][2] = MFMA32(pa1, __builtin_bit_cast(bf16x8, fb), o[s][2]); VRD(fb, vb3, 1);
                        VWT(1, fa); o[s][3] = MFMA32(pa0, __builtin_bit_cast(bf16x8, fa), o[s][3]);
                        VWT(0, fb); o[s][3] = MFMA32(pa1, __builtin_bit_cast(bf16x8, fb), o[s][3]);
#undef VRD
#undef VWT
                    }
                }
            }
        }
        if (j < jmax) DA_LSTORE((j + 1) & 1);
        __syncthreads();
    }
#undef DA_GLOAD
#undef DA_LSTORE
    ls[0] += __shfl_xor(ls[0], 32); ls[1] += __shfl_xor(ls[1], 32);
    if (hi == 0) { wsf[r32] = 1.0f / ls[0]; wsf[32 + r32] = lam / ls[1]; }
    bf16_t* Od = (bf16_t*)(ws + WS_OD) + (size_t)(b * SEQ + 256 * qb + 32 * wid) * 1024 + h * 128 + r32;
#pragma unroll
    for (int r = 0; r < 16; ++r) {
        const float f1 = wsf[crow(r, hi)], f2 = wsf[32 + crow(r, hi)];
        float v[4]; float ss = 0.f;
#pragma unroll
        for (int d0 = 0; d0 < 4; ++d0) { v[d0] = o[0][d0][r] * f1 - o[1][d0][r] * f2; ss += v[d0] * v[d0]; }
#pragma unroll
        for (int off = 1; off < 32; off <<= 1) ss += __shfl_xor(ss, off);
        const float rstd = rsqrtf(ss * (1.0f / 128.0f) + EPS);
#pragma unroll
        for (int d0 = 0; d0 < 4; ++d0) Od[(size_t)crow(r, hi) * 1024 + 32 * d0] = (bf16_t)(cvtpk(v[d0] * rstd, 0.f) & 0xffffu);
    }
}

__device__ __forceinline__ void sb_weights(f32x16& z0, f32x16& z1, float& R, int hi) {
    f32x16 s0, s1;
#pragma unroll
    for (int r = 0; r < 16; ++r) { z0[r] = ex2(z0[r]); z1[r] = ex2(z1[r]); s0[r] = __builtin_amdgcn_rcpf(1.0f + z0[r]); s1[r] = __builtin_amdgcn_rcpf(1.0f + z1[r]); }
    float gs[8], pg[8], off[8];
#pragma unroll
    for (int g = 0; g < 4; ++g) { gs[g] = (s0[4 * g] * s0[4 * g + 1]) * (s0[4 * g + 2] * s0[4 * g + 3]); gs[4 + g] = (s1[4 * g] * s1[4 * g + 1]) * (s1[4 * g + 2] * s1[4 * g + 3]); }
#pragma unroll
    for (int g = 0; g < 8; ++g) pg[g] = __shfl_xor(gs[g], 32);
    float run = ex2(-R);
#pragma unroll
    for (int g = 7; g >= 0; --g) { off[g] = run * (hi == 0 ? pg[g] : 1.0f); run *= gs[g] * pg[g]; }
    float tp = 1.0f;
#pragma unroll
    for (int g = 0; g < 8; ++g) tp *= gs[g] * pg[g];
    R -= lg2(tp);
#pragma unroll
    for (int g = 0; g < 4; ++g) {
        float c = off[g];
#pragma unroll
        for (int e = 3; e >= 0; --e) { c *= s0[4 * g + e]; z0[4 * g + e] *= c; }
        c = off[4 + g];
#pragma unroll
        for (int e = 3; e >= 0; --e) { c *= s1[4 * g + e]; z1[4 * g + e] *= c; }
    }
}

constexpr int SB_VOFF = 9216;
__device__ __forceinline__ void sb_unit(KArgs a, LAS unsigned char* lds, int b, int h, int qb) {
    const int tid = opaque_tid(), lane = tid & 63, r32 = lane & 31, hi = lane >> 5;
    const int wid = __builtin_amdgcn_readfirstlane(tid >> 6);
    unsigned char* ws = a->ws;
    const int rowb = b * TP;
    const int q0 = NMETA + 256 * qb + 32 * wid;
    const int jmax = 4 * qb + 4, jw = 4 * qb + (wid >> 1) + 1;
    const bf16_t* Kb = (const bf16_t*)(ws + WS_KS) + (size_t)rowb * 512 + h * 64;
    const bf16_t* Vb = (const bf16_t*)(ws + WS_VS) + (size_t)rowb * 512 + h * 64;
    bf16x8 q[4];
    { const bf16_t* Qp = (const bf16_t*)(ws + WS_QS) + (size_t)(rowb + q0 + r32) * 512 + h * 64 + hi * 8;
#pragma unroll
      for (int d0 = 0; d0 < 4; ++d0) q[d0] = *(const bf16x8*)(Qp + d0 * 16); }
    f32x16 o[2];
#pragma unroll
    for (int d0 = 0; d0 < 2; ++d0)
#pragma unroll
        for (int r = 0; r < 16; ++r) o[d0][r] = 0.f;
    float R = 0.f;
    const int kkv = tid >> 3, kdc = tid & 7;
    const int vkp = tid & 31, vdc = (tid >> 5) & 7;
    u32x4 kr, vr[2];
#define SB_GLOAD(j) do { \
        { int pos_ = 64 * (j) - 48 + kkv; pos_ = pos_ < 0 ? 0 : pos_; kr = *(const u32x4*)(Kb + (size_t)pos_ * 512 + kdc * 8); } \
        if (tid < 256) { _Pragma("unroll") for (int i_ = 0; i_ < 2; ++i_) { int pos_ = 64 * (j) - 48 + 2 * vkp + i_; pos_ = pos_ < 0 ? 0 : pos_; vr[i_] = *(const u32x4*)(Vb + (size_t)pos_ * 512 + vdc * 8); } } } while (0)
#define SB_LSTORE(s) do { LAS unsigned char* sb_ = lds + (s) * ATT_STAGE; \
        *(LAS u32x4*)(sb_ + kkv * 144 + kdc * 16) = kr; \
        if (tid < 256) { _Pragma("unroll") for (int e_ = 0; e_ < 8; ++e_) { const unsigned lo_ = (vr[0][e_ >> 1] >> (16 * (e_ & 1))) & 0xffffu, hi_ = (vr[1][e_ >> 1] >> (16 * (e_ & 1))) & 0xffffu; \
            *(LAS unsigned*)(sb_ + SB_VOFF + (8 * vdc + e_) * 136 + vkp * 4) = lo_ | (hi_ << 16); } } } while (0)
    SB_GLOAD(jmax); SB_LSTORE(0);
    __syncthreads();
    int st = 0;
    for (int j = jmax; j >= 0; --j) {
        if (j > 0) SB_GLOAD(j - 1);
        if (j <= jw) {
            const LAS unsigned char* Ks = lds + st * ATT_STAGE + r32 * 144 + hi * 16;
            const LAS unsigned char* Vs = lds + st * ATT_STAGE + SB_VOFF + r32 * 136 + hi * 8;
            f32x16 p0, p1;
#pragma unroll
            for (int r = 0; r < 16; ++r) { p0[r] = 0.f; p1[r] = 0.f; }
#pragma unroll
            for (int d0 = 0; d0 < 4; ++d0) {
                const bf16x8 ka = *(const LAS bf16x8*)(Ks + d0 * 32), kb = *(const LAS bf16x8*)(Ks + 32 * 144 + d0 * 32);
                p0 = MFMA32(ka, q[d0], p0); p1 = MFMA32(kb, q[d0], p1); }
            if (j == jw) { const int qrel = 32 * (wid & 1) + r32; asm volatile("" ::: "memory");
#pragma unroll
                for (int r = 0; r < 16; ++r) { if (crow(r, hi) >= qrel) p0[r] = -INFINITY; if (crow(r, hi) + 32 >= qrel) p1[r] = -INFINITY; } }
            if (j == 0) { asm volatile("" ::: "memory");
#pragma unroll
                for (int r = 0; r < 16; ++r) { p0[r] = -INFINITY; if (crow(r, hi) < 16) p1[r] = -INFINITY; } }
            sb_weights(p0, p1, R, hi);
            bf16x8 pa[4]; packP(p0, p1, pa);
            {
                const unsigned vb0 = (unsigned)(size_t)(Vs), vb1 = vb0 + 4352;
                u32x4 fa, fb;
#define VRD(dst_, base_, k_) asm volatile("ds_read2_b64 %0, %1 offset0:%2 offset1:%3" : "=v"(dst_) : "v"(base_), "n"((k_) * 4), "n"((k_) * 4 + 2) : "memory")
#define VWT(n_, dst_) asm volatile("s_waitcnt lgkmcnt(" #n_ ")" : "+v"(dst_) :: "memory")
                VRD(fa, vb0, 0); VRD(fb, vb0, 1);
                VWT(1, fa); o[0] = MFMA32(pa[0], __builtin_bit_cast(bf16x8, fa), o[0]); VRD(fa, vb0, 2);
                VWT(1, fb); o[0] = MFMA32(pa[1], __builtin_bit_cast(bf16x8, fb), o[0]); VRD(fb, vb0, 3);
                VWT(1, fa); o[0] = MFMA32(pa[2], __builtin_bit_cast(bf16x8, fa), o[0]); VRD(fa, vb1, 0);
                VWT(1, fb); o[0] = MFMA32(pa[3], __builtin_bit_cast(bf16x8, fb), o[0]); VRD(fb, vb1, 1);
                VWT(1, fa); o[1] = MFMA32(pa[0], __builtin_bit_cast(bf16x8, fa), o[1]); VRD(fa, vb1, 2);
                VWT(1, fb); o[1] = MFMA32(pa[1], __builtin_bit_cast(bf16x8, fb), o[1]); VRD(fb, vb1, 3);
                VWT(1, fa); o[1] = MFMA32(pa[2], __builtin_bit_cast(bf16x8, fa), o[1]);
                VWT(0, fb); o[1] = MFMA32(pa[3], __builtin_bit_cast(bf16x8, fb), o[1]);
#undef VRD
#undef VWT
            }
        }
        if (j > 0) SB_LSTORE(st ^ 1);
        __syncthreads();
        st ^= 1;
    }
#undef SB_GLOAD
#undef SB_LSTORE
    LAS bf16_t* stg = (LAS bf16_t*)(lds + wid * 4608);
#pragma unroll
    for (int r = 0; r < 16; ++r)
#pragma unroll
        for (int d0 = 0; d0 < 2; ++d0) stg[crow(r, hi) * 72 + 32 * d0 + r32] = (bf16_t)(cvtpk(o[d0][r], 0.f) & 0xffffu);
    bf16_t* Os = (bf16_t*)(ws + WS_OS) + (size_t)(b * SEQ + 256 * qb + 32 * wid) * 512 + h * 64;
#pragma unroll
    for (int i = 0; i < 4; ++i) { const int row = 8 * i + (lane >> 3), ch = lane & 7;
        *(u32x4*)(Os + (size_t)row * 512 + 8 * ch) = *(const LAS u32x4*)(stg + row * 72 + 8 * ch); }
    __syncthreads();
}

__device__ __forceinline__ bf16x8 ld8f(const float* p) { const f32x4 a = __builtin_nontemporal_load((const f32x4*)p), b = __builtin_nontemporal_load((const f32x4*)(p + 4));
    const u32x4 w = {cvtpk(a[0], a[1]), cvtpk(a[2], a[3]), cvtpk(b[0], b[1]), cvtpk(b[2], b[3])}; return __builtin_bit_cast(bf16x8, w); }

__device__ __forceinline__ void sample_unit(KArgs a, LAS unsigned char* lds, int b, int h, int split) {
    const int tid = opaque_tid(), lane = tid & 63, r32 = lane & 31, hi = lane >> 5;
    const int wid = __builtin_amdgcn_readfirstlane(tid >> 6);
    unsigned char* ws = a->ws;
    const int nt = 2;
    const int kbase = split * 1024 + wid * 128;
    const int srow = RP + b * DS;
    float* part = (float*)(ws + WS_PART) + (size_t)((b * 8 + h) * 4 + split) * PART_FLOATS;
    LAS float* wsf = (LAS float*)(lds + 65536) + wid * 64;
    LAS float* accs = (LAS float*)lds;
    LAS float* stat = (LAS float*)(lds + 32768);
    const unsigned koffL = (unsigned)(r32 * 1024 + hi * 8);
    const unsigned voffL4 = (unsigned)(4 * hi * 1024 + 4 * r32);
    int one_ = 1; asm volatile("" : "+s"(one_));
    for (int it_ = 0; it_ < one_; ++it_) { const int s = wid & 1; const int kb4 = split * 1024 + (wid >> 1) * 256;
        bf16x8 q[4];
        { const bf16_t* Qp = (const bf16_t*)(ws + WS_QD) + (size_t)(srow + r32) * 1024 + h * 128 + s * 64 + hi * 8;
#pragma unroll
          for (int d0 = 0; d0 < 4; ++d0) q[d0] = *(const bf16x8*)(Qp + d0 * 16); }
        f32x16 o[4];
#pragma unroll
        for (int d0 = 0; d0 < 4; ++d0)
#pragma unroll
            for (int r = 0; r < 16; ++r) o[d0][r] = 0.f;
        float mx = -INFINITY, ls = 0.f;
        for (int t = 3; t >= 0; --t) {
            const bool isnew = false;
            const float* kt = (isnew ? a->out + O_SDK + (size_t)(b * DS) * 1024 + h * 128 : a->in[I_CDK] + ((size_t)(b * PAST + kb4 + 64 * t) * 8 + h) * 128) + s * 64;
            const float* vt = isnew ? a->out + O_SDV + (size_t)(b * DS) * 1024 + h * 128 : a->in[I_CDV] + ((size_t)(b * PAST + kb4 + 64 * t) * 8 + h) * 128;
            f32x16 p0, p1;
#pragma unroll
            for (int r = 0; r < 16; ++r) { p0[r] = 0.f; p1[r] = 0.f; }
            { bf16x8 ka[4], kb[4];
#pragma unroll
              for (int d0 = 0; d0 < 4; ++d0) { ka[d0] = ld8f(kt + d0 * 16 + koffL); kb[d0] = ld8f(kt + 32 * 1024 + d0 * 16 + koffL); }
#pragma unroll
              for (int d0 = 0; d0 < 4; ++d0) { p0 = MFMA32(ka[d0], q[d0], p0); p1 = MFMA32(kb[d0], q[d0], p1); } }
            if (isnew) {
#pragma unroll
                for (int r = 0; r < 16; ++r) p1[r] = -INFINITY; }
            const float rm = rowmax32(p0, p1);
            if (__any(rm > mx + 8.0f)) {
                const float mn = fmaxf(mx, rm); const float f = ex2(mx - mn); mx = mn; ls *= f;
                if (hi == 0) wsf[r32] = f;
#pragma unroll
                for (int r = 0; r < 16; ++r) { const float fr_ = wsf[crow(r, hi)];
#pragma unroll
                    for (int d0 = 0; d0 < 4; ++d0) o[d0][r] *= fr_; }
            }
            float sum = 0.f;
#pragma unroll
            for (int r = 0; r < 16; ++r) { p0[r] = ex2(p0[r] - mx); p1[r] = ex2(p1[r] - mx); sum += p0[r] + p1[r]; }
            ls += sum;
            bf16x8 pa[4]; packP(p0, p1, pa);
#pragma unroll
            for (int kp = 0; kp < 2; ++kp) {
                if (isnew && kp == 1) break;
                f32x4 v[2][8];
#pragma unroll
                for (int k2 = 0; k2 < 2; ++k2)
#pragma unroll
                    for (int e = 0; e < 8; ++e) v[k2][e] = __builtin_nontemporal_load((const f32x4*)(vt + (16 * (2 * kp + k2) + (e & 3) + 8 * (e >> 2)) * 1024 + voffL4));
#pragma unroll
                for (int k2 = 0; k2 < 2; ++k2)
#pragma unroll
                    for (int d0 = 0; d0 < 4; ++d0) { float t[8];
#pragma unroll
                        for (int e = 0; e < 8; ++e) t[e] = v[k2][e][d0];
                        const u32x4 vv = pack8(t); o[d0] = MFMA32(pa[2 * kp + k2], __builtin_bit_cast(bf16x8, vv), o[d0]); }
            }
        }
        ls += __shfl_xor(ls, 32);
        if (hi == 0) stat[wid * 32 + r32] = mx;
        __syncthreads();
        float mb = stat[s * 32 + r32];
#pragma unroll
        for (int j = 1; j < 4; ++j) mb = fmaxf(mb, stat[(2 * j + s) * 32 + r32]);
        const float fw = ex2(mx - mb);
        if (hi == 0) wsf[r32] = fw;
        LAS float* lacc = stat + 512;
        for (int w = 0; w < 4; ++w) {
            if ((wid >> 1) == w) {
#pragma unroll
                for (int r = 0; r < 16; ++r) { const int qq = crow(r, hi); const float f = wsf[qq];
#pragma unroll
                    for (int d0 = 0; d0 < 4; ++d0) { LAS float* p = accs + (s * 32 + qq) * 128 + 4 * r32 + d0; const float v = o[d0][r] * f; *p = (w == 0) ? v : *p + v; } }
                if (hi == 0) { LAS float* p = lacc + s * 32 + r32; const float v = ls * fw; *p = (w == 0) ? v : *p + v; }
            }
            __syncthreads();
        }
        if (wid < 2 && hi == 0) { part[s * 64 + r32] = mb; part[s * 64 + 32 + r32] = lacc[s * 32 + r32]; }
    }
    for (int i = tid; i < 2048; i += 512) *(f32x4*)(part + 128 + 4 * i) = *(const LAS f32x4*)(accs + 4 * i);
    __syncthreads();
    {
        bf16x8 q[4];
        { const bf16_t* Qp = (const bf16_t*)(ws + WS_QS) + (size_t)(srow + r32) * 512 + h * 64 + hi * 8;
#pragma unroll
          for (int d0 = 0; d0 < 4; ++d0) q[d0] = *(const bf16x8*)(Qp + d0 * 16); }
        f32x16 o[2];
#pragma unroll
        for (int d0 = 0; d0 < 2; ++d0)
#pragma unroll
            for (int r = 0; r < 16; ++r) o[d0][r] = 0.f;
        float R = 0.f;
        const unsigned koffS = (unsigned)(r32 * 512 + hi * 8), voffS2 = (unsigned)(4 * hi * 512 + 2 * r32);
        for (int t = nt - 1; t >= 0; --t) {
            asm volatile("" ::: "memory");
            const bool isnew = (t == 2);
            const float* kt = isnew ? a->out + O_SSK + (size_t)(b * DS) * 512 + h * 64 : a->in[I_CSK] + ((size_t)(b * PAST + kbase + 64 * t) * 8 + h) * 64;
            const float* vt = isnew ? a->out + O_SSV + (size_t)(b * DS) * 512 + h * 64 : a->in[I_CSV] + ((size_t)(b * PAST + kbase + 64 * t) * 8 + h) * 64;
            f32x16 p0, p1;
#pragma unroll
            for (int r = 0; r < 16; ++r) { p0[r] = 0.f; p1[r] = 0.f; }
            { bf16x8 ka[4], kb[4];
#pragma unroll
              for (int d0 = 0; d0 < 4; ++d0) { ka[d0] = ld8f(kt + d0 * 16 + koffS); kb[d0] = ld8f(kt + 32 * 512 + d0 * 16 + koffS); }
#pragma unroll
              for (int d0 = 0; d0 < 4; ++d0) { p0 = MFMA32(ka[d0], q[d0], p0); p1 = MFMA32(kb[d0], q[d0], p1); } }
            if (isnew) {
#pragma unroll
                for (int r = 0; r < 16; ++r) { p1[r] = -INFINITY; if (crow(r, hi) >= r32) p0[r] = -INFINITY; } }
            sb_weights(p0, p1, R, hi);
            bf16x8 pa[4]; packP(p0, p1, pa);
            {
                f32x2_t v[4][8];
#pragma unroll
                for (int ks = 0; ks < 4; ++ks)
#pragma unroll
                    for (int e = 0; e < 8; ++e) v[ks][e] = (isnew && ks >= 2) ? (f32x2_t){0.f, 0.f} : __builtin_nontemporal_load((const f32x2_t*)(vt + (16 * ks + (e & 3) + 8 * (e >> 2)) * 512 + voffS2));
#pragma unroll
                for (int ks = 0; ks < 4; ++ks)
#pragma unroll
                    for (int d0 = 0; d0 < 2; ++d0) { float t[8];
#pragma unroll
                        for (int e = 0; e < 8; ++e) t[e] = v[ks][e][d0];
                        const u32x4 vv = pack8(t); o[d0] = MFMA32(pa[ks], __builtin_bit_cast(bf16x8, vv), o[d0]); }
            }
        }
        if (hi == 0) stat[wid * 32 + r32] = R;
        __syncthreads();
        float offs = 0.f, tot = 0.f;
#pragma unroll
        for (int w = 0; w < 8; ++w) { const float t_ = stat[w * 32 + r32]; tot += t_; if (w > wid) offs += t_; }
        if (hi == 0) wsf[r32] = ex2(-offs);
        for (int w = 0; w < 8; ++w) {
            if (wid == w) {
#pragma unroll
                for (int r = 0; r < 16; ++r) { const int qq = crow(r, hi); const float f = wsf[qq];
#pragma unroll
                    for (int d0 = 0; d0 < 2; ++d0) { LAS float* p = accs + qq * 64 + 2 * r32 + d0; const float v = o[d0][r] * f; *p = (w == 0) ? v : *p + v; } }
            }
            __syncthreads();
        }
        if (tid < 32) part[8320 + tid] = tot;
        { const int i = tid; *(f32x4*)(part + 8352 + 4 * i) = *(const LAS f32x4*)(accs + 4 * i); }
        __syncthreads();
    }
}

__device__ __forceinline__ void sample_combine(KArgs a, LAS unsigned char* lds, int b, int h, float lam) {
    const int tid = opaque_tid(), lane = tid & 63, r32 = lane & 31, hi = lane >> 5;
    const int wid = __builtin_amdgcn_readfirstlane(tid >> 6);
    unsigned char* ws = a->ws;
    const float* part = (const float*)(ws + WS_PART) + (size_t)((b * 8 + h) * 4) * PART_FLOATS;
    LAS float* np = (LAS float*)lds;
    const int srow = RP + b * DS;
    if (wid == 0) {
#pragma unroll
        for (int s = 0; s < 2; ++s) {
            f32x16 p;
#pragma unroll
            for (int r = 0; r < 16; ++r) p[r] = 0.f;
            { const bf16_t* kp = (const bf16_t*)(ws + WS_KD) + (size_t)(srow + r32) * 1024 + h * 128 + s * 64 + hi * 8;
              const bf16_t* qp = (const bf16_t*)(ws + WS_QD) + (size_t)(srow + r32) * 1024 + h * 128 + s * 64 + hi * 8;
#pragma unroll
              for (int d0 = 0; d0 < 4; ++d0) p = MFMA32(*(const bf16x8*)(kp + d0 * 16), *(const bf16x8*)(qp + d0 * 16), p); }
            float m = fmaxf(p[0], p[1]);
#pragma unroll
            for (int r = 2; r < 16; ++r) m = fmaxf(m, p[r]);
            m = fmaxf(m, __shfl_xor(m, 32));
            float l = 0.f;
#pragma unroll
            for (int r = 0; r < 16; ++r) { p[r] = ex2(p[r] - m); l += p[r]; }
            l += __shfl_xor(l, 32);
            const u32x4 w0 = {cvtpk(p[0], p[1]), cvtpk(p[2], p[3]), cvtpk(p[4], p[5]), cvtpk(p[6], p[7])}, w1 = {cvtpk(p[8], p[9]), cvtpk(p[10], p[11]), cvtpk(p[12], p[13]), cvtpk(p[14], p[15])};
            const bf16_t* vp = (const bf16_t*)(ws + WS_VD) + (size_t)(srow + 4 * hi) * 1024 + h * 128 + r32;
#pragma unroll
            for (int d0 = 0; d0 < 4; ++d0) {
                f32x16 o;
#pragma unroll
                for (int r = 0; r < 16; ++r) o[r] = 0.f;
#pragma unroll
                for (int ks = 0; ks < 2; ++ks) { unsigned w[4];
#pragma unroll
                    for (int e2 = 0; e2 < 4; ++e2) { const int e = 2 * e2;
                        const unsigned lo = vp[(size_t)(16 * ks + (e & 3) + 8 * (e >> 2)) * 1024 + 32 * d0], hi_ = vp[(size_t)(16 * ks + ((e + 1) & 3) + 8 * ((e + 1) >> 2)) * 1024 + 32 * d0]; w[e2] = lo | (hi_ << 16); }
                    const u32x4 vv = {w[0], w[1], w[2], w[3]};
                    o = MFMA32(__builtin_bit_cast(bf16x8, ks ? w1 : w0), __builtin_bit_cast(bf16x8, vv), o); }
#pragma unroll
                for (int r = 0; r < 16; ++r) np[128 + (s * 32 + crow(r, hi)) * 128 + 32 * d0 + r32] = o[r];
            }
            if (hi == 0) { np[s * 64 + r32] = m; np[s * 64 + 32 + r32] = l; }
        }
        {
            f32x16 p0, p1;
#pragma unroll
            for (int r = 0; r < 16; ++r) { p0[r] = 0.f; p1[r] = -INFINITY; }
            { const bf16_t* kp = (const bf16_t*)(ws + WS_KS) + (size_t)(srow + r32) * 512 + h * 64 + hi * 8;
              const bf16_t* qp = (const bf16_t*)(ws + WS_QS) + (size_t)(srow + r32) * 512 + h * 64 + hi * 8;
#pragma unroll
              for (int d0 = 0; d0 < 4; ++d0) p0 = MFMA32(*(const bf16x8*)(kp + d0 * 16), *(const bf16x8*)(qp + d0 * 16), p0); }
#pragma unroll
            for (int r = 0; r < 16; ++r) if (crow(r, hi) >= r32) p0[r] = -INFINITY;
            float R = 0.f;
            sb_weights(p0, p1, R, hi);
            const u32x4 w0 = {cvtpk(p0[0], p0[1]), cvtpk(p0[2], p0[3]), cvtpk(p0[4], p0[5]), cvtpk(p0[6], p0[7])}, w1 = {cvtpk(p0[8], p0[9]), cvtpk(p0[10], p0[11]), cvtpk(p0[12], p0[13]), cvtpk(p0[14], p0[15])};
            const bf16_t* vp = (const bf16_t*)(ws + WS_VS) + (size_t)(srow + 4 * hi) * 512 + h * 64 + r32;
#pragma unroll
            for (int d0 = 0; d0 < 2; ++d0) {
                f32x16 o;
#pragma unroll
                for (int r = 0; r < 16; ++r) o[r] = 0.f;
#pragma unroll
                for (int ks = 0; ks < 2; ++ks) { unsigned w[4];
#pragma unroll
                    for (int e2 = 0; e2 < 4; ++e2) { const int e = 2 * e2;
                        const unsigned lo = vp[(size_t)(16 * ks + (e & 3) + 8 * (e >> 2)) * 512 + 32 * d0], hi_ = vp[(size_t)(16 * ks + ((e + 1) & 3) + 8 * ((e + 1) >> 2)) * 512 + 32 * d0]; w[e2] = lo | (hi_ << 16); }
                    const u32x4 vv = {w[0], w[1], w[2], w[3]};
                    o = MFMA32(__builtin_bit_cast(bf16x8, ks ? w1 : w0), __builtin_bit_cast(bf16x8, vv), o); }
#pragma unroll
                for (int r = 0; r < 16; ++r) np[8352 + crow(r, hi) * 64 + 32 * d0 + r32] = o[r];
            }
            if (hi == 0) np[8320 + r32] = R;
        }
    }
    __syncthreads();
    {
        const int qq = tid >> 4, c = tid & 15;
        float v[2][8];
#pragma unroll
        for (int s = 0; s < 2; ++s) {
            float m[5], l[5], M = -INFINITY;
#pragma unroll
            for (int sp = 0; sp < 4; ++sp) { m[sp] = part[sp * PART_FLOATS + s * 64 + qq]; l[sp] = part[sp * PART_FLOATS + s * 64 + 32 + qq]; M = fmaxf(M, m[sp]); }
            m[4] = np[s * 64 + qq]; l[4] = np[s * 64 + 32 + qq]; M = fmaxf(M, m[4]);
            float L = 0.f;
#pragma unroll
            for (int i = 0; i < 8; ++i) v[s][i] = 0.f;
#pragma unroll
            for (int sp = 0; sp < 5; ++sp) { const float f = ex2(m[sp] - M); L += l[sp] * f;
                f32x4 x0, x1;
                if (sp < 4) { const float* op = part + sp * PART_FLOATS + 128 + (s * 32 + qq) * 128 + 8 * c; x0 = *(const f32x4*)op; x1 = *(const f32x4*)(op + 4); }
                else { const LAS float* op = np + 128 + (s * 32 + qq) * 128 + 8 * c; x0 = *(const LAS f32x4*)op; x1 = *(const LAS f32x4*)(op + 4); }
#pragma unroll
                for (int i = 0; i < 4; ++i) { v[s][i] += x0[i] * f; v[s][4 + i] += x1[i] * f; } }
            const float inv = 1.0f / L;
#pragma unroll
            for (int i = 0; i < 8; ++i) v[s][i] *= inv;
        }
        float y[8]; float ss = 0.f;
#pragma unroll
        for (int i = 0; i < 8; ++i) { y[i] = v[0][i] - lam * v[1][i]; ss += y[i] * y[i]; }
#pragma unroll
        for (int off = 1; off < 16; off <<= 1) ss += __shfl_xor(ss, off);
        const float rstd = rsqrtf(ss * (1.0f / 128.0f) + EPS);
#pragma unroll
        for (int i = 0; i < 8; ++i) y[i] *= rstd;
        *(u32x4*)((bf16_t*)(ws + WS_OD) + (size_t)(RC + b * DS + qq) * 1024 + h * 128 + 8 * c) = pack8(y);
    }
    if (tid < 256) {
        const int qq = tid >> 3, c = tid & 7;
        float y[8];
        { const LAS float* op = np + 8352 + qq * 64 + 8 * c; const f32x4 x0 = *(const LAS f32x4*)op, x1 = *(const LAS f32x4*)(op + 4);
#pragma unroll
          for (int i = 0; i < 4; ++i) { y[i] = x0[i]; y[4 + i] = x1[i]; } }
        float offs = np[8320 + qq];
#pragma unroll
        for (int sp = 3; sp >= 0; --sp) { const float f = ex2(-offs);
            const float* op = part + sp * PART_FLOATS + 8352 + qq * 64 + 8 * c; const f32x4 x0 = *(const f32x4*)op, x1 = *(const f32x4*)(op + 4);
#pragma unroll
            for (int i = 0; i < 4; ++i) { y[i] += x0[i] * f; y[4 + i] += x1[i] * f; }
            offs += part[sp * PART_FLOATS + 8320 + qq]; }
        *(u32x4*)((bf16_t*)(ws + WS_OS) + (size_t)(RC + b * DS + qq) * 512 + h * 64 + 8 * c) = pack8(y);
    }
    __syncthreads();
}

__device__ __forceinline__ int phys_row0(int cb) { const int q = cb & 7; return (cb >> 3) * 256 + 32 * (4 * (q & 1) + (q >> 1)); }
__device__ __forceinline__ void skinny_acc(f32x16& acc, const bf16_t* A, const bf16_t* Bt, int K, int row0, int prow0, int wid, int r32, int hi) {
    const int kw = K >> 3;
    const bf16_t* ap = A + (size_t)(row0 + r32) * K + wid * kw + hi * 8;
    const bf16_t* bp = Bt + (size_t)(prow0 + r32) * K + wid * kw + hi * 8;
#pragma unroll 16
    for (int k = 0; k < kw; k += 16) { const bf16x8 av = *(const bf16x8*)(ap + k), bv = *(const bf16x8*)(bp + k); acc = MFMA32(av, bv, acc); }
}
__device__ __forceinline__ void skinny_acc2(f32x16& acc, f32x16& acc2, const bf16_t* A, const bf16_t* Bt, int K, int row0, int prow0, int prow1, int wid, int r32, int hi) {
    const int kw = K >> 3;
    const bf16_t* ap = A + (size_t)(row0 + r32) * K + wid * kw + hi * 8;
    const bf16_t* bp = Bt + (size_t)(prow0 + r32) * K + wid * kw + hi * 8;
    const bf16_t* bq = Bt + (size_t)(prow1 + r32) * K + wid * kw + hi * 8;
#pragma unroll 8
    for (int k = 0; k < kw; k += 16) { const bf16x8 av = *(const bf16x8*)(ap + k), bv = *(const bf16x8*)(bp + k), bw = *(const bf16x8*)(bq + k); acc = MFMA32(av, bv, acc); acc2 = MFMA32(av, bw, acc2); }
}
__device__ __forceinline__ void skinny_put(LAS float* red, const f32x16& acc, int wid, int r32, int hi) {
#pragma unroll
    for (int r = 0; r < 16; ++r) red[(wid * 32 + crow(r, hi)) * 33 + r32] = acc[r];
}
__device__ __forceinline__ void skinny_get(const LAS float* red, int row, int col, float& s0, float& s1) {
    s0 = 0.f; s1 = 0.f;
#pragma unroll
    for (int w = 0; w < 8; ++w) { s0 += red[(w * 32 + row) * 33 + col]; s1 += red[(w * 32 + row) * 33 + col + 1]; }
}
constexpr size_t WS_SSS = WS_SS + 1280 * 1024;
__device__ __forceinline__ void skinny_phase(KArgs a, LAS unsigned char* lds, int which, int vcu, int G) {
    const int tid = opaque_tid(), lane = tid & 63, r32 = lane & 31, hi = lane >> 5;
    const int wid = __builtin_amdgcn_readfirstlane(tid >> 6);
    unsigned char* ws = a->ws;
    LAS float* red = (LAS float*)lds; LAS float* red2 = (LAS float*)(lds + 34816);
    const int row = tid >> 4, col = 2 * (tid & 15);
    const int nunits = (which == 2) ? 512 : 256;
    for (int u = vcu; u < nunits; u += G) {
        const int rb = u & 7; int cb = (which == 2) ? 2 * (u >> 3) : (u >> 3);
        const int row0 = RC + 32 * rb, prow0 = phys_row0(cb);
        const int grow = row0 + row, srow = grow - RC; int gcol = 32 * cb + col;
        f32x16 acc, acc2;
#pragma unroll
        for (int r = 0; r < 16; ++r) { acc[r] = 0.f; acc2[r] = 0.f; }
        if (which == 0) {
            skinny_acc(acc, (const bf16_t*)(ws + WS_OD), (const bf16_t*)(ws + WS_WDO), 1024, row0, prow0, wid, r32, hi);
            skinny_acc(acc2, (const bf16_t*)(ws + WS_OS), (const bf16_t*)(ws + WS_WSO), 512, row0, prow0, wid, r32, hi);
            skinny_put(red, acc, wid, r32, hi); skinny_put(red2, acc2, wid, r32, hi);
        } else if (which == 1) {
            skinny_acc(acc, (const bf16_t*)(ws + WS_XN), (const bf16_t*)(ws + WS_WOUT), 1024, row0, prow0, wid, r32, hi);
            skinny_put(red, acc, wid, r32, hi);
        } else if (which == 2) {
            skinny_acc2(acc, acc2, (const bf16_t*)(ws + WS_OD), (const bf16_t*)(ws + WS_W1), 1024, row0, prow0, phys_row0(cb + 1), wid, r32, hi);
            skinny_put(red, acc, wid, r32, hi); skinny_put(red2, acc2, wid, r32, hi);
        } else {
            skinny_acc(acc, (const bf16_t*)(ws + WS_H), (const bf16_t*)(ws + WS_W2), 4096, row0, prow0, wid, r32, hi);
            skinny_put(red, acc, wid, r32, hi);
        }
        __syncthreads();
        float s0, s1; skinny_get(red, row, col, s0, s1);
        if (which == 0) {
            float t0, t1; skinny_get(red2, row, col, t0, t1);
            const unsigned gd = *(const unsigned*)((const bf16_t*)(ws + WS_G) + (size_t)grow * 2048 + gcol), gs = *(const unsigned*)((const bf16_t*)(ws + WS_G) + (size_t)grow * 2048 + 1024 + gcol);
            *(unsigned*)((bf16_t*)(ws + WS_XN) + (size_t)grow * 1024 + gcol) = cvtpk(bf_lo(gd) * s0 + bf_lo(gs) * t0, bf_hi(gd) * s1 + bf_hi(gs) * t1);
        } else if (which == 1) {
            const float* xr = a->in[I_XS] + (size_t)srow * 1024 + gcol;
            const float v0 = xr[0] + s0, v1 = xr[1] + s1;
            *(f32x2_t*)((float*)(ws + WS_G) + (size_t)grow * 1024 + gcol) = (f32x2_t){v0, v1};
            *(unsigned*)((bf16_t*)(ws + WS_OD) + (size_t)grow * 1024 + gcol) = cvtpk(v0, v1);
            float ss = v0 * v0 + v1 * v1;
#pragma unroll
            for (int off = 1; off < 16; off <<= 1) ss += __shfl_xor(ss, off);
            if ((tid & 15) == 0) ((float*)(ws + WS_SSS))[srow * 32 + cb] = ss;
        } else if (which == 2) {
            const float* sp = (const float*)(ws + WS_SSS) + srow * 32 + col;
            float ss = sp[0] + sp[1];
#pragma unroll
            for (int off = 1; off < 16; off <<= 1) ss += __shfl_xor(ss, off);
            const float r2 = 1.0f / (ss * (1.0f / 1024.0f) + EPS);
            const float h0 = fmaxf(s0, 0.f), h1 = fmaxf(s1, 0.f);
            *(unsigned*)((bf16_t*)(ws + WS_H) + (size_t)grow * 4096 + gcol) = cvtpk(h0 * h0 * r2, h1 * h1 * r2);
            float t0, t1; skinny_get(red2, row, col, t0, t1);
            const float h2 = fmaxf(t0, 0.f), h3 = fmaxf(t1, 0.f);
            *(unsigned*)((bf16_t*)(ws + WS_H) + (size_t)grow * 4096 + gcol + 32) = cvtpk(h2 * h2 * r2, h3 * h3 * r2);
        } else {
            const float* xr = (const float*)(ws + WS_G) + (size_t)grow * 1024 + gcol;
            *(f32x2_t*)(a->out + O_YS + (size_t)srow * 1024 + gcol) = (f32x2_t){xr[0] + s0, xr[1] + s1};
        }
        __syncthreads();
    }
}

#define XB_TMO      128
#define XB_XCNT(j)  (256  + 64 * (j))
#define XB_XSUB(j)  (1280 + 64 * (j))
#define XB_XGEN(j)  (2304 + 64 * (j))
#define XB_TOP      3328
#define XB_TOPGEN   3392
#define XCD_BAR_WORDS 3456
#define XB_SPIN_CAP (1u << 18)

__device__ __forceinline__ unsigned xb_ld(unsigned* p)              { return __hip_atomic_load(p, __ATOMIC_RELAXED, __HIP_MEMORY_SCOPE_AGENT); }
__device__ __forceinline__ unsigned xb_add(unsigned* p, unsigned v) { return __hip_atomic_fetch_add(p, v, __ATOMIC_RELAXED, __HIP_MEMORY_SCOPE_AGENT); }
__device__ __forceinline__ unsigned xb_xcc_id() { return (unsigned)__builtin_amdgcn_s_getreg((3 << 11) | 20) & 0xFu; }
#define XB_SPIN(cond, bar) do { unsigned _sp = 0; while (cond) { __builtin_amdgcn_s_sleep(1); \
    if ((++_sp & 255u) == 0u) { if (xb_ld(&(bar)[XB_TMO])) break; if (_sp > XB_SPIN_CAP) { atomicAdd(&(bar)[XB_TMO], 1u); break; } } } } while (0)

struct XcdBarrier {
    unsigned* bar; unsigned x;
    volatile LAS unsigned* st;
};

__device__ __forceinline__ XcdBarrier xcd_barrier_post(unsigned* bar, volatile LAS unsigned* st) {
    XcdBarrier b; b.bar = bar; b.x = xb_xcc_id(); b.st = st;
    if (threadIdx.x == 0) (void)xb_add(&bar[XB_XCNT(b.x)], 1u);
    return b;
}
__device__ __forceinline__ void xcd_barrier_complete(unsigned* bar, unsigned x, unsigned& nloc, unsigned& nx) {
    const unsigned G = gridDim.x * gridDim.y * gridDim.z;
    unsigned sum, cnt, mine, sp = 0u;
    for (;;) {
        sum = 0u; cnt = 0u; mine = 0u;
#pragma unroll
        for (unsigned j = 0; j < 16; ++j) { const unsigned c = xb_ld(&bar[XB_XCNT(j)]); sum += c; cnt += (c > 0u) ? 1u : 0u; mine = (j == x) ? c : mine; }
        if (sum == G) break;
        __builtin_amdgcn_s_sleep(1);
        if ((++sp & 255u) == 0u) { if (xb_ld(&bar[XB_TMO])) break; if (sp > XB_SPIN_CAP) { atomicAdd(&bar[XB_TMO], 1u); break; } }
    }
    nloc = mine > 0u ? mine : 1u; nx = cnt > 0u ? cnt : 1u;
}

__device__ __forceinline__ void xcd_barrier(const XcdBarrier& b) {
    asm volatile("s_waitcnt vmcnt(0)" ::: "memory");
    __syncthreads();
    if (threadIdx.x == 0) {
        unsigned* bar = b.bar;
        __builtin_amdgcn_s_waitcnt(0);
        unsigned nloc = b.st[0], nx = b.st[1];
        if (nloc == 0u) { xcd_barrier_complete(bar, b.x, nloc, nx); b.st[0] = nloc; b.st[1] = nx; }
        const unsigned old = xb_add(&bar[XB_XSUB(b.x)], 1u);
        const unsigned gen = old / nloc;
        if (old + 1u == (gen + 1u) * nloc) {
            __builtin_amdgcn_fence(__ATOMIC_RELEASE, "agent");
            asm volatile("s_waitcnt vmcnt(0)" ::: "memory");
            const unsigned og = xb_add(&bar[XB_TOP], 1u);
            const unsigned tg = og / nx;
            if (og + 1u == (tg + 1u) * nx) xb_add(&bar[XB_TOPGEN], 1u);
            else XB_SPIN(xb_ld(&bar[XB_TOPGEN]) == tg, bar);
            __builtin_amdgcn_fence(__ATOMIC_ACQUIRE, "agent");
            xb_add(&bar[XB_XGEN(b.x)], 1u);
            asm volatile("s_waitcnt vmcnt(0)" ::: "memory");
        } else {
            XB_SPIN(xb_ld(&bar[XB_XGEN(b.x)]) == gen, bar);
            __builtin_amdgcn_fence(__ATOMIC_ACQUIRE, "agent");
            asm volatile("s_waitcnt vmcnt(0)" ::: "memory");
        }
    }
    __syncthreads();
}

__global__ void __launch_bounds__(512, 2) mega_fwd(Args a_) {
    extern __shared__ __attribute__((aligned(16))) unsigned char lds_raw[];
    LAS unsigned char* lds = (LAS unsigned char*)lds_raw;
    cg::grid_group grid = cg::this_grid();
    const int G = gridDim.x, bx = blockIdx.x;
    const int vcu = (G % 8 == 0) ? (bx % 8) * (G / 8) + bx / 8 : bx;
    KArgs a = (KArgs)__builtin_amdgcn_kernarg_segment_ptr();
#define RELOAD_ARGS() asm volatile("" : "+s"(a))
    unsigned char* ws;

    volatile LAS unsigned* bst = (volatile LAS unsigned*)(lds + LDS_BYTES - 64);
    if (threadIdx.x < 2) bst[threadIdx.x] = 0u;
    RELOAD_ARGS();
    __syncthreads();
    { int never = 0; asm volatile("" : "+s"(never)); if (never) grid.sync(); }
    RELOAD_ARGS();
    (void)xcd_barrier_post((unsigned*)(a->ws + WS_BAR), bst);
#define SEAM() do { RELOAD_ARGS(); XcdBarrier xb_; xb_.bar = (unsigned*)(a->ws + WS_BAR); xb_.x = xb_xcc_id(); xb_.st = bst; xcd_barrier(xb_); } while (0)
    RELOAD_ARGS();
    for (int rep_ = 0; rep_ < REP_P0; ++rep_) prologue(a, lds, vcu, G);
    SEAM();

    for (int rep_ = 0; rep_ < REP_SYNC; ++rep_) SEAM();
    RELOAD_ARGS(); ws = a->ws;
    for (int rep_ = 0; rep_ < REP_P1; ++rep_)
    {
        pg8::Gemm g{(const bf16_t*)(ws + WS_XN), (const bf16_t*)(ws + WS_WIN), M1, NIN, 1024}; pg8::StaticOrder S; S.init(M1, NIN, G, bx);
        EpiIn E{a->out, ws, a->in[I_QG], a->in[I_KG]};
        pg8::gemm_phase<EpiIn, pg8::StaticOrder, true, true>(lds, g, S, E);
    }
    { constexpr int NU = (M1 / 256) * (NIN / 256); const int full = NU / G, first_idle = NU - full * G;
      if (first_idle > 0 && first_idle < G) { if (bx >= first_idle) { RELOAD_ARGS(); convert_late_weights(a, lds, bx - first_idle, G - first_idle); } }
      else { RELOAD_ARGS(); convert_late_weights(a, lds, bx, G); } }
    SEAM();


    RELOAD_ARGS(); ws = a->ws;
    for (int rep_ = 0; rep_ < REP_P2A; ++rep_)
    for (int u = vcu; u < DB * 8 * 4; u += G) { int uu = u; asm volatile("" : "+s"(uu)); RELOAD_ARGS(); sample_unit(a, lds, uu >> 5, (uu >> 2) & 7, uu & 3); }
    SEAM();

    RELOAD_ARGS(); ws = a->ws;
    float lam;
    { const int lane = opaque_tid() & 63;
      const float s1 = wave_sum(a->in[I_LQ1][lane] * a->in[I_LK1][lane]), s2 = wave_sum(a->in[I_LQ2][lane] * a->in[I_LK2][lane]);
      lam = __builtin_bit_cast(float, __builtin_amdgcn_readfirstlane(__builtin_bit_cast(int, __expf(s1) - __expf(s2) + LAM_INIT))); }
    for (int u = vcu; u < DB * 8; u += G) sample_combine(a, lds, u >> 3, u & 7, lam);
    for (int rep_ = 0; rep_ < REP_P2B; ++rep_)
    for (int u = vcu; u < NBATCH * 8 * 8; u += G) {
        const int bh = u >> 3, s = u & 7, b = bh >> 3, h = bh & 7;
        for (int k = 0; k < 2 * REP_DIFF; ++k) { int qb = (k & 1) ? 15 - s : s, bb = b, hh = h; asm volatile("" : "+s"(qb), "+s"(bb), "+s"(hh)); RELOAD_ARGS(); diff_unit1(a, lds, bb, hh, qb, lam); }
        for (int k = 0; k < 2 * REP_SB; ++k) { int qb = (k & 1) ? 15 - s : s, bb = b, hh = h; asm volatile("" : "+s"(qb), "+s"(bb), "+s"(hh)); RELOAD_ARGS(); sb_unit(a, lds, bb, hh, qb); }
    }
    SEAM();

    for (int rep3_ = 0; rep3_ < REP_P3; ++rep3_) {
    RELOAD_ARGS(); ws = a->ws;
    {
        pg8::Gemm g{(const bf16_t*)(ws + WS_OD), (const bf16_t*)(ws + WS_WDO), RC, 1024, 1024}; pg8::StaticOrder S; S.init(RC, 1024, G, bx);
        EpiGateA E{(const bf16_t*)(ws + WS_G), (float*)(ws + WS_T1)};
        pg8::gemm_phase<EpiGateA, pg8::StaticOrder, true, true>(lds, g, S, E);
    }
    __syncthreads();
    RELOAD_ARGS(); ws = a->ws;
    {
        pg8::Gemm g{(const bf16_t*)(ws + WS_OS), (const bf16_t*)(ws + WS_WSO), RC, 1024, 512}; pg8::StaticOrder S; S.init(RC, 1024, G, bx);
        EpiGateB E{(const bf16_t*)(ws + WS_G), (const float*)(ws + WS_T1), (bf16_t*)(ws + WS_XN)};
        pg8::gemm_phase<EpiGateB, pg8::StaticOrder, true, true>(lds, g, S, E);
    }
    RELOAD_ARGS(); skinny_phase(a, lds, 0, vcu, G);
    __syncthreads();
    }
    SEAM();

    RELOAD_ARGS(); ws = a->ws;
    for (int rep_ = 0; rep_ < REP_P4; ++rep_)
    {
        pg8::Gemm g{(const bf16_t*)(ws + WS_XN), (const bf16_t*)(ws + WS_WOUT), RC, 1024, 1024}; pg8::StaticOrder S; S.init(RC, 1024, G, bx);
        EpiOut E{a->in[I_XP], a->in[I_XS], (float*)(ws + WS_G), (bf16_t*)(ws + WS_OD), (float*)(ws + WS_SS)};
        pg8::gemm_phase<EpiOut, pg8::StaticOrder, true, true>(lds, g, S, E);
    }
    RELOAD_ARGS(); skinny_phase(a, lds, 1, vcu, G);
    SEAM();

    RELOAD_ARGS(); ws = a->ws;
    for (int rep_ = 0; rep_ < REP_P5; ++rep_)
    {
        pg8::Gemm g{(const bf16_t*)(ws + WS_OD), (const bf16_t*)(ws + WS_W1), RC, DFF, 1024}; pg8::StaticOrder S; S.init(RC, DFF, G, bx);
        EpiFF1 E{(const float*)(ws + WS_SS), (bf16_t*)(ws + WS_H)};
        pg8::gemm_phase<EpiFF1, pg8::StaticOrder, true, true>(lds, g, S, E);
    }
    RELOAD_ARGS(); skinny_phase(a, lds, 2, vcu, G);
    SEAM();

    RELOAD_ARGS(); ws = a->ws;
    for (int rep_ = 0; rep_ < REP_P6; ++rep_)
    {
        pg8::Gemm g{(const bf16_t*)(ws + WS_H), (const bf16_t*)(ws + WS_W2), RC, 1024, DFF}; pg8::StaticOrder S; S.init(RC, 1024, G, bx);
        EpiFF2 E{(const float*)(ws + WS_G), a->out};
        pg8::gemm_phase<EpiFF2, pg8::StaticOrder, true, true>(lds, g, S, E);
    }
    RELOAD_ARGS(); skinny_phase(a, lds, 3, vcu, G);
}

extern "C" void kernel_launch(void* const* d_in, const int* in_sizes, int n_in, void* d_out, int out_size, void* d_ws, size_t ws_size, hipStream_t stream) {
    static int grid = 0;
    if (grid == 0) {
        if (n_in != 22 || ws_size < WS_END) { fprintf(stderr, "kernel_launch: unexpected n_in %d / ws %zu\n", n_in, ws_size); grid = -1; return; }
        int dev = 0, cus = 0, per_cu = 0;
        hipGetDevice(&dev);
        hipDeviceGetAttribute(&cus, hipDeviceAttributeMultiprocessorCount, dev);
        hipFuncSetAttribute((const void*)mega_fwd, hipFuncAttributeMaxDynamicSharedMemorySize, LDS_BYTES);
        hipOccupancyMaxActiveBlocksPerMultiprocessor(&per_cu, (const void*)mega_fwd, 512, LDS_BYTES);
        if (per_cu < 1) { fprintf(stderr, "kernel_launch: occupancy query says %d blocks/CU\n", per_cu); per_cu = 1; }
        (void)hipGetLastError();
        grid = cus * 1;
    }
    if (grid < 0) return;
    Args a{};
    for (int i = 0; i < 22; ++i) a.in[i] = (const float*)d_in[i];
    a.out = (float*)d_out; a.ws = (unsigned char*)d_ws;
    if (hipMemsetAsync((unsigned char*)d_ws + WS_BAR, 0, XCD_BAR_WORDS * 4, stream) != hipSuccess) { fprintf(stderr, "kernel_launch: hipMemsetAsync failed\n"); return; }
    void* args[] = {&a};
    hipError_t e = hipLaunchCooperativeKernel((const void*)mega_fwd, dim3(grid), dim3(512), args, LDS_BYTES, stream);
    if (e != hipSuccess) fprintf(stderr, "cooperative launch failed: %s (grid %d)\n", hipGetErrorString(e), grid);
}
```

```cpp
#include <hip/hip_runtime.h>
#include <hip/hip_cooperative_groups.h>
#include <cstdio>
#include <cstdint>
namespace cg = cooperative_groups;
__device__ __forceinline__ int opaque_tid() { int t = threadIdx.x; asm volatile("" : "+v"(t)); return t; }
namespace pg8 {
#define PG8_LAS __attribute__((address_space(3)))
typedef unsigned short bf16_t;
typedef short bf16x8 __attribute__((ext_vector_type(8)));
typedef float f32x4 __attribute__((ext_vector_type(4)));
typedef unsigned u32x4 __attribute__((ext_vector_type(4)));
constexpr int BM = 256, BK = 64, HALF = 128, HTB = HALF * BK * 2  , STAGE_BYTES = 8 * HTB, NXCD = 8, WGM = 8;

__host__ __device__ __forceinline__ int lds_byte(int r, int c) { const int st = (r >> 4) * 2 + (c >> 5), rr = r & 15, cc = c & 31, ob = rr * 64 + cc * 2; return st * 1024 + (ob ^ (((ob >> 9) & 1) << 5)); }
__host__ __device__ __forceinline__ void stage_rc(int b, int& R, int& C) { const int st = b / 1024, sb = b % 1024, swz = sb ^ (((sb >> 9) & 1) << 5); R = (st >> 1) * 16 + swz / 64; C = (st & 1) * 32 + (swz % 64) / 2; }
__host__ __device__ __forceinline__ int perm32(int rho) { const int n = rho >> 4, i = rho & 15; return 8 * (i >> 2) + 4 * n + (i & 3); }

struct Unit { int pm, pn; };
struct Gemm { const bf16_t* A; const bf16_t* Bt; int M, N, K; };

struct StaticOrder {
    int nM, nN, nwg, G, c;
    __host__ __device__ void init(int M, int N, int G_, int c_) { nM = M / BM; nN = N / BM; nwg = nM * nN; G = G_; c = c_; }
    __host__ __device__ bool next(int i, Unit& u) const {
        const long L = (long)i * G + c; if (L >= nwg) return false;
        int wgid = (int)L; { const int q = nwg / NXCD, r = nwg % NXCD, xcd = wgid % NXCD, off = wgid / NXCD; wgid = (xcd < r ? xcd * (q + 1) : r * (q + 1) + (xcd - r) * q) + off; }
        const int nig = WGM * nN, gid = wgid / nig, fm = gid * WGM, gsz = (nM - fm) < WGM ? (nM - fm) : WGM;
        u.pm = fm + ((wgid % nig) % gsz); u.pn = (wgid % nig) / gsz; return true;
    }
    __device__ __forceinline__ void a_ready(const Unit&) const {}
    __device__ __forceinline__ void done(const Unit&) const {}
};

__device__ __forceinline__ unsigned cvt_pk_bf16(float lo, float hi) { unsigned r; asm volatile("v_cvt_pk_bf16_f32 %0, %1, %2" : "=v"(r) : "v"(lo), "v"(hi)); return r; }
typedef float f32x2 __attribute__((ext_vector_type(2)));
template <class Epi, class Sched, bool ALIGN_EPI = false, bool SP2 = false>
__device__ __forceinline__ void gemm_phase(PG8_LAS unsigned char* lds, const Gemm g, const Sched& S, const Epi& E) {
    const int tid = opaque_tid(), wid = __builtin_amdgcn_readfirstlane(tid >> 6), lane = tid & 63, wr = wid >> 2, wc = wid & 3, fr = lane & 15, fq = lane >> 4;
    const int K = g.K, nt = K / BK;
    unsigned voffA[2], voffB[2];
#pragma unroll
    for (int i = 0; i < 2; ++i) { int R, C; stage_rc(tid * 16 + i * 8192, R, C); const int Rb = Epi::PERM ? ((R & ~31) + perm32(R & 31)) : R;
        voffA[i] = (unsigned)(R * K + C) * 2u; voffB[i] = (unsigned)(Rb * K + C) * 2u; }
    const size_t kstep = (size_t)(BK * 2);
    const size_t hstep = (size_t)HALF * K * 2;
    const size_t tstep = 2 * hstep;
    const unsigned ldsw = (unsigned)wid * 1024u;
    const int aoff = lds_byte(wr * 64 + fr, fq * 8), boff = lds_byte(wc * 32 + fr, fq * 8);
#define PG8_SA(b, h) (((b) * 2 + (h)) * HTB)
#define PG8_SB(b, h) ((4 + (b) * 2 + (h)) * HTB)
#define PG8_STAGE(bufoff, gbase, voff) do { _Pragma("unroll") for (int _i = 0; _i < 2; ++_i) \
        __builtin_amdgcn_global_load_lds((const unsigned*)((const char*)(gbase) + (voff)[_i]), (PG8_LAS unsigned*)(lds + (bufoff) + ldsw + _i * 8192), 16, 0, 0); } while (0)
#define PG8_LDA(dst, b, h) do { _Pragma("unroll") for (int m = 0; m < 4; ++m) _Pragma("unroll") for (int k = 0; k < 2; ++k) dst[m][k] = *(const PG8_LAS bf16x8*)(lds + PG8_SA(b, h) + aoff + m * 2048 + k * 1024); } while (0)
#define PG8_LDB(dst, b, h) do { _Pragma("unroll") for (int n = 0; n < 2; ++n) _Pragma("unroll") for (int k = 0; k < 2; ++k) dst[n][k] = *(const PG8_LAS bf16x8*)(lds + PG8_SB(b, h) + boff + n * 2048 + k * 1024); } while (0)
#define PG8_MMA(ai, bj, At, Bt) do { __builtin_amdgcn_s_setprio(1); _Pragma("unroll") for (int m = 0; m < 4; ++m) _Pragma("unroll") for (int n = 0; n < 2; ++n) _Pragma("unroll") for (int k = 0; k < 2; ++k) \
        acc[ai][bj][m][n] = __builtin_amdgcn_mfma_f32_16x16x32_bf16(Bt[n][k], At[m][k], acc[ai][bj][m][n], 0, 0, 0); __builtin_amdgcn_s_setprio(0); } while (0)
#define PG8_WAIT_V(n) asm volatile("s_waitcnt vmcnt(" #n ")" ::: "memory")
#define PG8_WAIT_L(n) asm volatile("s_waitcnt lgkmcnt(" #n ")" ::: "memory")
#define PG8_BAR __builtin_amdgcn_s_barrier()
#define PG8_SCHED __builtin_amdgcn_sched_barrier(0)
    Unit cur, nxt; int ui = 0;
    if (!S.next(0, cur)) return;
    f32x4 acc[2][2][4][2];
#pragma unroll
    for (int a = 0; a < 2; ++a)
#pragma unroll
        for (int b = 0; b < 2; ++b)
#pragma unroll
            for (int m = 0; m < 4; ++m)
#pragma unroll
                for (int n = 0; n < 2; ++n) acc[a][b][m][n] = (f32x4){0.f, 0.f, 0.f, 0.f};
    bf16x8 At[4][2], B0[2][2], B1[2][2];
    const char* cA = (const char*)g.A + (size_t)cur.pm * tstep; const char* cB = (const char*)g.Bt + (size_t)cur.pn * tstep;
    S.a_ready(cur);
    if constexpr (SP2) {
        PG8_STAGE(PG8_SB(0, 0), cB, voffB); PG8_STAGE(PG8_SB(0, 1), cB + hstep, voffB); PG8_STAGE(PG8_SA(0, 0), cA, voffA); PG8_STAGE(PG8_SA(0, 1), cA + hstep, voffA);
        if (wr == 1) PG8_BAR;
        PG8_WAIT_V(2); PG8_BAR;
        PG8_STAGE(PG8_SB(1, 0), cB + kstep, voffB); PG8_STAGE(PG8_SA(1, 0), cA + kstep, voffA); PG8_STAGE(PG8_SB(1, 1), cB + hstep + kstep, voffB);
        PG8_WAIT_V(6); PG8_BAR;
    } else {
        PG8_STAGE(PG8_SB(0, 0), cB, voffB); PG8_STAGE(PG8_SA(0, 0), cA, voffA); PG8_STAGE(PG8_SB(0, 1), cB + hstep, voffB); PG8_STAGE(PG8_SA(0, 1), cA + hstep, voffA);
        if (wr == 1) PG8_BAR;
        PG8_WAIT_V(4); PG8_BAR;
        PG8_STAGE(PG8_SB(1, 0), cB + kstep, voffB); PG8_STAGE(PG8_SA(1, 0), cA + kstep, voffA); PG8_STAGE(PG8_SB(1, 1), cB + hstep + kstep, voffB);
        PG8_WAIT_V(6); PG8_BAR;
    }
    for (;;) {
        const bool has_next = S.next(ui + 1, nxt);
        const char* nA = has_next ? (const char*)g.A + (size_t)nxt.pm * tstep : cA; const char* nB = has_next ? (const char*)g.Bt + (size_t)nxt.pn * tstep : cB;
        for (int t = 0; t < nt; t += 2) {
            const bool last = (t == nt - 2);
            const char* a1 = cA + (size_t)(t + 1) * kstep;
            const char* a2 = last ? nA : cA + (size_t)(t + 2) * kstep; const char* b2 = last ? nB : cB + (size_t)(t + 2) * kstep;
            const char* a3 = a2 + kstep; const char* b3 = b2 + kstep;
            if (last && has_next) S.a_ready(nxt);
            if constexpr (SP2) {
            PG8_LDB(B0, 0, 0); PG8_LDB(B1, 0, 1); PG8_SCHED; PG8_LDA(At, 0, 0); PG8_STAGE(PG8_SA(1, 1), a1 + hstep, voffA);
            PG8_WAIT_V(8); PG8_WAIT_L(0); PG8_BAR; PG8_MMA(0, 0, At, B0); PG8_MMA(0, 1, At, B1); PG8_BAR; PG8_SCHED;
            PG8_LDA(At, 0, 1); PG8_STAGE(PG8_SB(0, 0), b2, voffB); PG8_STAGE(PG8_SB(0, 1), b2 + hstep, voffB); PG8_STAGE(PG8_SA(0, 0), a2, voffA);
            PG8_WAIT_V(8); PG8_WAIT_L(0); PG8_BAR; PG8_MMA(1, 0, At, B0); PG8_MMA(1, 1, At, B1); PG8_BAR; PG8_SCHED;
            PG8_LDB(B0, 1, 0); PG8_LDB(B1, 1, 1); PG8_SCHED; PG8_LDA(At, 1, 0); PG8_STAGE(PG8_SA(0, 1), a2 + hstep, voffA);
            PG8_WAIT_V(8); PG8_WAIT_L(0); PG8_BAR; PG8_MMA(0, 0, At, B0); PG8_MMA(0, 1, At, B1); PG8_BAR; PG8_SCHED;
            PG8_LDA(At, 1, 1); PG8_STAGE(PG8_SB(1, 0), b3, voffB); PG8_STAGE(PG8_SB(1, 1), b3 + hstep, voffB); PG8_STAGE(PG8_SA(1, 0), a3, voffA);
            PG8_WAIT_V(8); PG8_WAIT_L(0); PG8_BAR; PG8_MMA(1, 0, At, B0); PG8_MMA(1, 1, At, B1); PG8_BAR; PG8_SCHED;
            } else {
            PG8_LDB(B0, 0, 0); PG8_SCHED; PG8_LDA(At, 0, 0); PG8_STAGE(PG8_SA(1, 1), a1 + hstep, voffA);
            PG8_WAIT_L(8); PG8_BAR; PG8_WAIT_L(0); PG8_MMA(0, 0, At, B0); PG8_BAR; PG8_SCHED;
            PG8_LDB(B1, 0, 1); PG8_STAGE(PG8_SB(0, 0), b2, voffB);
            PG8_BAR; PG8_WAIT_L(0); PG8_MMA(0, 1, At, B1); PG8_BAR;
            PG8_LDA(At, 0, 1); PG8_STAGE(PG8_SA(0, 0), a2, voffA);
            PG8_BAR; PG8_WAIT_L(0); PG8_MMA(1, 0, At, B0); PG8_BAR; PG8_SCHED;
            PG8_STAGE(PG8_SB(0, 1), b2 + hstep, voffB);
            PG8_WAIT_V(6); PG8_BAR; PG8_MMA(1, 1, At, B1); PG8_BAR;
            PG8_LDB(B0, 1, 0); PG8_SCHED; PG8_LDA(At, 1, 0); PG8_STAGE(PG8_SA(0, 1), a2 + hstep, voffA);
            PG8_WAIT_L(8); PG8_BAR; PG8_WAIT_L(0); PG8_MMA(0, 0, At, B0); PG8_BAR; PG8_SCHED;
            PG8_LDB(B1, 1, 1); PG8_STAGE(PG8_SB(1, 0), b3, voffB);
            PG8_BAR; PG8_WAIT_L(0); PG8_MMA(0, 1, At, B1); PG8_BAR;
            PG8_LDA(At, 1, 1); PG8_STAGE(PG8_SA(1, 0), a3, voffA);
            PG8_BAR; PG8_WAIT_L(0); PG8_MMA(1, 0, At, B0); PG8_BAR; PG8_SCHED;
            PG8_STAGE(PG8_SB(1, 1), b3 + hstep, voffB);
            PG8_WAIT_V(6); PG8_BAR; PG8_MMA(1, 1, At, B1); PG8_BAR;
            }
        }
        if constexpr (ALIGN_EPI) { if (wr == 0) PG8_BAR; }
        if constexpr (!Epi::AFTER_DRAIN) { E(acc, cur, wr, wc, fr, fq); S.done(cur); }
        if (!has_next) break;
#pragma unroll
        for (int a = 0; a < 2; ++a)
#pragma unroll
            for (int b = 0; b < 2; ++b)
#pragma unroll
                for (int m = 0; m < 4; ++m)
#pragma unroll
                    for (int n = 0; n < 2; ++n) acc[a][b][m][n] = (f32x4){0.f, 0.f, 0.f, 0.f};
        cur = nxt; cA = nA; cB = nB; ++ui;
        if constexpr (ALIGN_EPI) { if (wr == 1) PG8_BAR; }
    }
    PG8_WAIT_V(0);
    if constexpr (!ALIGN_EPI) { if (wr == 0) PG8_BAR; }
    PG8_BAR;
    if constexpr (Epi::AFTER_DRAIN) { E.fused(acc, cur, wr, wc, fr, fq, lds, wid, lane); S.done(cur); }
#undef PG8_SA
#undef PG8_SB
#undef PG8_STAGE
#undef PG8_LDA
#undef PG8_LDB
#undef PG8_MMA
#undef PG8_WAIT_V
#undef PG8_WAIT_L
#undef PG8_BAR
#undef PG8_SCHED
}
}

#define LAS __attribute__((address_space(3)))
typedef unsigned short bf16_t;
typedef short bf16x8 __attribute__((ext_vector_type(8)));
typedef float f32x4 __attribute__((ext_vector_type(4)));
typedef float f32x16 __attribute__((ext_vector_type(16)));
typedef unsigned u32x4 __attribute__((ext_vector_type(4)));
typedef unsigned u32x2 __attribute__((ext_vector_type(2)));
typedef float f32x2_t __attribute__((ext_vector_type(2)));
typedef __bf16 bf16x2_t __attribute__((ext_vector_type(2)));

constexpr int DM = 1024, NBATCH = 4, SEQ = 4096, NMETA = 16, TP = SEQ + NMETA;
constexpr int DB = 8, DS = 32, PAST = 4096;
constexpr int RP = NBATCH * TP;
constexpr int RS = DB * DS;
constexpr int R1 = RP + RS;
constexpr int M1 = 16896;
constexpr int RC = NBATCH * SEQ;
constexpr int M2 = RC + RS;
constexpr int NIN = 6656, DFF = 4096;
constexpr float EPS = 1e-6f;
constexpr float QSCALE = 0.18033688011112042f;
constexpr float LAM_INIT = 0.2f;

constexpr size_t O_Y = 0, O_YS = 16777216, O_PDK = 17039360, O_PDV = 33882112, O_PSK = 50724864, O_PSV = 59146240,
                 O_SDK = 67567616, O_SDV = 67829760, O_SSK = 68091904, O_SSV = 68222976;

constexpr size_t MiB = 1u << 20;
constexpr size_t WS_WIN = 0, WS_WDO = 14 * MiB, WS_WSO = 16 * MiB, WS_WOUT = 17 * MiB, WS_W1 = 19 * MiB, WS_W2 = 27 * MiB;
constexpr size_t WS_ROPE = 35 * MiB, WS_SS = 36 * MiB, WS_BAR = 36 * MiB + 1536 * 1024, WS_PART = 38 * MiB;
constexpr size_t WS_XN = 50 * MiB;
constexpr size_t WS_QD = 83 * MiB, WS_KD = 116 * MiB, WS_VD = 149 * MiB;
constexpr size_t WS_QS = 182 * MiB, WS_KS = 199 * MiB, WS_VS = 216 * MiB;
constexpr size_t WS_T1 = 83 * MiB;
constexpr size_t WS_H = 83 * MiB;
constexpr size_t WS_G = 233 * MiB;
constexpr size_t WS_OD = 298 * MiB;
constexpr size_t WS_OS = 331 * MiB;
constexpr size_t WS_END = 348 * MiB;
constexpr int PART_FLOATS = 10400;

constexpr int LDS_BYTES = 147456;
#ifndef REP_P0
#define REP_P0 1
#endif
#ifndef REP_P1
#define REP_P1 1
#endif
#ifndef REP_P4
#define REP_P4 1
#endif
#ifndef REP_P5
#define REP_P5 1
#endif
#ifndef REP_P6
#define REP_P6 1
#endif
#ifndef REP_SYNC
#define REP_SYNC 0
#endif
#ifndef REP_DIFF
#define REP_DIFF 1
#endif
#ifndef REP_SB
#define REP_SB 1
#endif
#ifndef REP_P3
#define REP_P3 1
#endif
#ifndef REP_P2A
#define REP_P2A 1
#endif
#ifndef REP_P2B
#define REP_P2B 1
#endif

__device__ __forceinline__ unsigned cvtpk(float lo, float hi) { f32x2_t v = {lo, hi}; bf16x2_t b = __builtin_convertvector(v, bf16x2_t); return __builtin_bit_cast(unsigned, b); }
__device__ __forceinline__ float bf_lo(unsigned u) { return __uint_as_float(u << 16); }
__device__ __forceinline__ float bf_hi(unsigned u) { return __uint_as_float(u & 0xffff0000u); }
__device__ __forceinline__ int crow(int r, int hi) { return (r & 3) + 8 * (r >> 2) + 4 * hi; }
__device__ __forceinline__ float ex2(float x) { return __builtin_amdgcn_exp2f(x); }
__device__ __forceinline__ float lg2(float x) { return __builtin_amdgcn_logf(x); }
__device__ __forceinline__ float wave_sum(float v) {
#pragma unroll
    for (int o = 1; o < 64; o <<= 1) v += __shfl_xor(v, o);
    return v;
}
__device__ __forceinline__ u32x4 pack8(const float* v) { u32x4 w; w.x = cvtpk(v[0], v[1]); w.y = cvtpk(v[2], v[3]); w.z = cvtpk(v[4], v[5]); w.w = cvtpk(v[6], v[7]); return w; }

struct Args { const float* in[22]; float* out; unsigned char* ws; };
typedef const __attribute__((address_space(4))) Args* KArgs;
enum { I_XP = 0, I_XS, I_CDK, I_CDV, I_CSK, I_CSV, I_META, I_GMIX, I_WIN, I_QG, I_KG, I_LQ1, I_LK1, I_LQ2, I_LK2, I_SUBG, I_WDO, I_WSO, I_WOUT, I_GFFN, I_W1, I_W2 };

struct EpiIn {
    static constexpr bool PERM = true, AFTER_DRAIN = false;
    float* out; unsigned char* ws; const float* qg; const float* kg;
    __device__ __forceinline__ void operator()(const f32x4 (&acc)[2][2][4][2], const pg8::Unit& u, int wr, int wc, int fr, int fq) const {
        const int pn = u.pn;
        int type, cb;
        if (pn < 4) { type = 0; cb = 0; } else if (pn < 8) { type = 1; cb = 1024; } else if (pn < 12) { type = 2; cb = 2048; }
        else if (pn < 14) { type = 3; cb = 3072; } else if (pn < 16) { type = 4; cb = 3584; } else if (pn < 18) { type = 5; cb = 4096; } else { type = 6; cb = 4608; }
        const int col0 = pn * 256 + wc * 64 + fq * 8 - cb;
        const float* rope = (const float*)(ws + WS_ROPE);
        float gv[2][8];
        if (type <= 1) { const float* g = (type == 0) ? qg : kg;
#pragma unroll
            for (int bj = 0; bj < 2; ++bj)
#pragma unroll
                for (int i = 0; i < 8; ++i) gv[bj][i] = g[32 * bj + 8 * fq + i]; }
        bf16_t* bdst; int bld; size_t op, os; int ow;
        switch (type) {
            case 0: bdst = (bf16_t*)(ws + WS_QD); bld = 1024; op = 0; os = 0; ow = 0; break;
            case 1: bdst = (bf16_t*)(ws + WS_KD); bld = 1024; op = O_PDK; os = O_SDK; ow = 1024; break;
            case 2: bdst = (bf16_t*)(ws + WS_VD); bld = 1024; op = O_PDV; os = O_SDV; ow = 1024; break;
            case 3: bdst = (bf16_t*)(ws + WS_QS); bld = 512; op = 0; os = 0; ow = 0; break;
            case 4: bdst = (bf16_t*)(ws + WS_KS); bld = 512; op = O_PSK; os = O_SSK; ow = 512; break;
            case 5: bdst = (bf16_t*)(ws + WS_VS); bld = 512; op = O_PSV; os = O_SSV; ow = 512; break;
            default: bdst = (bf16_t*)(ws + WS_G); bld = 2048; op = 0; os = 0; ow = 0; break;
        }
#pragma unroll
        for (int ai = 0; ai < 2; ++ai)
#pragma unroll
            for (int m = 0; m < 4; ++m) {
                const int row = u.pm * 256 + ai * 128 + wr * 64 + m * 16 + fr;
                const bool valid = row < R1;
                const bool samp = row >= RP;
                int pos, crw;
                if (!samp) { const int b = row / TP; const int t = row - b * TP; pos = t; crw = (t >= NMETA) ? b * SEQ + t - NMETA : -1; }
                else { const int r = row - RP; pos = valid ? PAST + (r & 31) : 0; crw = RC + r; }
                float v[2][8];
#pragma unroll
                for (int bj = 0; bj < 2; ++bj)
#pragma unroll
                    for (int n = 0; n < 2; ++n)
#pragma unroll
                        for (int e = 0; e < 4; ++e) v[bj][4 * n + e] = acc[ai][bj][m][n][e];
                if (type <= 1) {
                    float ss = 0.f;
#pragma unroll
                    for (int bj = 0; bj < 2; ++bj)
#pragma unroll
                        for (int i = 0; i < 8; ++i) ss += v[bj][i] * v[bj][i];
                    ss += __shfl_xor(ss, 16); ss += __shfl_xor(ss, 32);
                    const float rstd = rsqrtf(ss * (1.0f / 64.0f) + EPS);
#pragma unroll
                    for (int bj = 0; bj < 2; ++bj)
#pragma unroll
                        for (int i = 0; i < 8; ++i) v[bj][i] *= rstd * gv[bj][i];
                    float pv[8];
#pragma unroll
                    for (int i = 0; i < 8; ++i) pv[i] = __shfl_xor(v[0][i], 16);
                    if (fq < 2) { const float* rp = rope + pos * 16;
#pragma unroll
                        for (int i = 0; i < 8; ++i) { const float c = rp[i], s = rp[8 + i]; v[0][i] = (fq == 0) ? (v[0][i] * c - pv[i] * s) : (v[0][i] * c + pv[i] * s); } }
                }
                if (type == 0 || type == 3) {
#pragma unroll
                    for (int bj = 0; bj < 2; ++bj)
#pragma unroll
                        for (int i = 0; i < 8; ++i) v[bj][i] *= QSCALE;
                }
                if (type == 6) {
#pragma unroll
                    for (int bj = 0; bj < 2; ++bj)
#pragma unroll
                        for (int i = 0; i < 8; ++i) v[bj][i] = __builtin_amdgcn_rcpf(1.0f + __expf(-v[bj][i]));
                }
                const int brow = (type == 6) ? crw : row;
                if (valid && brow >= 0) {
#pragma unroll
                    for (int bj = 0; bj < 2; ++bj) {
                        const int c = col0 + 32 * bj;
                        *(u32x4*)(bdst + (size_t)brow * bld + c) = pack8(v[bj]);
                        if (ow) { float* o = samp ? out + os + (size_t)(row - RP) * ow + c : out + op + (size_t)row * ow + c;
                            __builtin_nontemporal_store((f32x4){v[bj][0], v[bj][1], v[bj][2], v[bj][3]}, (f32x4*)o); __builtin_nontemporal_store((f32x4){v[bj][4], v[bj][5], v[bj][6], v[bj][7]}, (f32x4*)(o + 4)); }
                    }
                }
            }
    }
};

struct EpiGateA {
    static constexpr bool PERM = true, AFTER_DRAIN = false;
    const bf16_t* G; float* T1;
    __device__ __forceinline__ void operator()(const f32x4 (&acc)[2][2][4][2], const pg8::Unit& u, int wr, int wc, int fr, int fq) const {
        const int row0 = u.pm * 256 + wr * 64 + fr, c0 = u.pn * 256 + wc * 64 + fq * 8;
        u32x4 g[2][4][2];
#pragma unroll
        for (int ai = 0; ai < 2; ++ai)
#pragma unroll
            for (int m = 0; m < 4; ++m)
#pragma unroll
                for (int bj = 0; bj < 2; ++bj) g[ai][m][bj] = *(const u32x4*)(G + (size_t)(row0 + ai * 128 + m * 16) * 2048 + c0 + bj * 32);
#pragma unroll
        for (int ai = 0; ai < 2; ++ai)
#pragma unroll
            for (int m = 0; m < 4; ++m)
#pragma unroll
                for (int bj = 0; bj < 2; ++bj) { const u32x4 gg = g[ai][m][bj];
                    const f32x4 a0 = acc[ai][bj][m][0], a1 = acc[ai][bj][m][1];
                    bf16_t* t = (bf16_t*)T1 + (size_t)(row0 + ai * 128 + m * 16) * 1024 + c0 + bj * 32;
                    float v[8] = {bf_lo(gg.x) * a0[0], bf_hi(gg.x) * a0[1], bf_lo(gg.y) * a0[2], bf_hi(gg.y) * a0[3], bf_lo(gg.z) * a1[0], bf_hi(gg.z) * a1[1], bf_lo(gg.w) * a1[2], bf_hi(gg.w) * a1[3]};
                    *(u32x4*)t = pack8(v); }
    }
};
struct EpiGateB {
    static constexpr bool PERM = true, AFTER_DRAIN = false;
    const bf16_t* G; const float* T1; bf16_t* MG;
    __device__ __forceinline__ void operator()(const f32x4 (&acc)[2][2][4][2], const pg8::Unit& u, int wr, int wc, int fr, int fq) const {
        const int row0 = u.pm * 256 + wr * 64 + fr, c0 = u.pn * 256 + wc * 64 + fq * 8;
#pragma unroll
        for (int ai = 0; ai < 2; ++ai)
#pragma unroll
            for (int mh = 0; mh < 2; ++mh) {
                u32x4 g[2][2], tb[2][2];
#pragma unroll
                for (int mm = 0; mm < 2; ++mm)
#pragma unroll
                    for (int bj = 0; bj < 2; ++bj) { const size_t r = (size_t)(row0 + ai * 128 + (2 * mh + mm) * 16); const int c = c0 + bj * 32;
                        g[mm][bj] = *(const u32x4*)(G + r * 2048 + 1024 + c); tb[mm][bj] = *(const u32x4*)((const bf16_t*)T1 + r * 1024 + c); }
#pragma unroll
                for (int mm = 0; mm < 2; ++mm)
#pragma unroll
                    for (int bj = 0; bj < 2; ++bj) { const int m = 2 * mh + mm; const size_t r = (size_t)(row0 + ai * 128 + m * 16); const int c = c0 + bj * 32;
                        const u32x4 gg = g[mm][bj]; const f32x4 a0 = acc[ai][bj][m][0], a1 = acc[ai][bj][m][1]; const u32x4 tt = tb[mm][bj];
                        const f32x4 x0 = {bf_lo(tt.x), bf_hi(tt.x), bf_lo(tt.y), bf_hi(tt.y)}, x1 = {bf_lo(tt.z), bf_hi(tt.z), bf_lo(tt.w), bf_hi(tt.w)};
                        float v[8] = {x0[0] + bf_lo(gg.x) * a0[0], x0[1] + bf_hi(gg.x) * a0[1], x0[2] + bf_lo(gg.y) * a0[2], x0[3] + bf_hi(gg.y) * a0[3],
                                      x1[0] + bf_lo(gg.z) * a1[0], x1[1] + bf_hi(gg.z) * a1[1], x1[2] + bf_lo(gg.w) * a1[2], x1[3] + bf_hi(gg.w) * a1[3]};
                        *(u32x4*)(MG + r * 1024 + c) = pack8(v); }
            }
    }
};
struct EpiOut {
    static constexpr bool PERM = true, AFTER_DRAIN = false;
    const float* xp; const float* xs; float* X1; bf16_t* X1b; float* SS;
    __device__ __forceinline__ void operator()(const f32x4 (&acc)[2][2][4][2], const pg8::Unit& u, int wr, int wc, int fr, int fq) const {
        const int row0 = u.pm * 256 + wr * 64 + fr, c0 = u.pn * 256 + wc * 64 + fq * 8;
#pragma unroll
        for (int ai = 0; ai < 2; ++ai) {
            f32x4 xv[4][2][2];
#pragma unroll
            for (int m = 0; m < 4; ++m) { const int row = row0 + ai * 128 + m * 16;
                const float* xr = (row < RC) ? xp + (size_t)row * 1024 : xs + (size_t)(row - RC) * 1024;
#pragma unroll
                for (int bj = 0; bj < 2; ++bj) { xv[m][bj][0] = __builtin_nontemporal_load((const f32x4*)(xr + c0 + bj * 32)); xv[m][bj][1] = __builtin_nontemporal_load((const f32x4*)(xr + c0 + bj * 32 + 4)); } }
#pragma unroll
            for (int m = 0; m < 4; ++m) { const int row = row0 + ai * 128 + m * 16;
                float ss = 0.f;
#pragma unroll
                for (int bj = 0; bj < 2; ++bj) { const int c = c0 + bj * 32;
                    const f32x4 a0 = acc[ai][bj][m][0] + xv[m][bj][0], a1 = acc[ai][bj][m][1] + xv[m][bj][1];
                    *(f32x4*)(X1 + (size_t)row * 1024 + c) = a0; *(f32x4*)(X1 + (size_t)row * 1024 + c + 4) = a1;
                    float v[8] = {a0[0], a0[1], a0[2], a0[3], a1[0], a1[1], a1[2], a1[3]};
                    *(u32x4*)(X1b + (size_t)row * 1024 + c) = pack8(v);
#pragma unroll
                    for (int i = 0; i < 8; ++i) ss += v[i] * v[i]; }
                ss += __shfl_xor(ss, 16); ss += __shfl_xor(ss, 32);
                if (fq == 0) SS[(size_t)row * 16 + u.pn * 4 + wc] = ss; }
        }
    }
};
struct EpiFF1 {
    static constexpr bool PERM = true, AFTER_DRAIN = false;
    const float* SS; bf16_t* H;
    __device__ __forceinline__ void operator()(const f32x4 (&acc)[2][2][4][2], const pg8::Unit& u, int wr, int wc, int fr, int fq) const {
        const int row0 = u.pm * 256 + wr * 64 + fr, c0 = u.pn * 256 + wc * 64 + fq * 8;
#pragma unroll
        for (int ai = 0; ai < 2; ++ai) {
            f32x4 sv[4][4];
#pragma unroll
            for (int m = 0; m < 4; ++m) { const f32x4* sp = (const f32x4*)(SS + (size_t)(row0 + ai * 128 + m * 16) * 16);
#pragma unroll
                for (int i = 0; i < 4; ++i) sv[m][i] = sp[i]; }
#pragma unroll
            for (int m = 0; m < 4; ++m) { const int row = row0 + ai * 128 + m * 16;
                const f32x4 s0 = sv[m][0], s1 = sv[m][1], s2 = sv[m][2], s3 = sv[m][3];
                const float s = ((s0[0] + s0[1]) + (s0[2] + s0[3])) + ((s1[0] + s1[1]) + (s1[2] + s1[3])) + ((s2[0] + s2[1]) + (s2[2] + s2[3])) + ((s3[0] + s3[1]) + (s3[2] + s3[3]));
                const float r2 = 1.0f / (s * (1.0f / 1024.0f) + EPS);
#pragma unroll
                for (int bj = 0; bj < 2; ++bj) { float v[8];
#pragma unroll
                    for (int n = 0; n < 2; ++n)
#pragma unroll
                        for (int e = 0; e < 4; ++e) { const float a = fmaxf(acc[ai][bj][m][n][e], 0.f); v[4 * n + e] = a * a * r2; }
                    *(u32x4*)(H + (size_t)row * 4096 + c0 + bj * 32) = pack8(v); } }
        }
    }
};
struct EpiFF2 {
    static constexpr bool PERM = true, AFTER_DRAIN = false;
    const float* X1; float* out;
    __device__ __forceinline__ void operator()(const f32x4 (&acc)[2][2][4][2], const pg8::Unit& u, int wr, int wc, int fr, int fq) const {
        const int row0 = u.pm * 256 + wr * 64 + fr, c0 = u.pn * 256 + wc * 64 + fq * 8;
#pragma unroll
        for (int ai = 0; ai < 2; ++ai) {
            f32x4 xv[4][2][2];
#pragma unroll
            for (int m = 0; m < 4; ++m) { const float* xr = X1 + (size_t)(row0 + ai * 128 + m * 16) * 1024 + c0;
#pragma unroll
                for (int bj = 0; bj < 2; ++bj) { xv[m][bj][0] = *(const f32x4*)(xr + bj * 32); xv[m][bj][1] = *(const f32x4*)(xr + bj * 32 + 4); } }
#pragma unroll
            for (int m = 0; m < 4; ++m) { const int row = row0 + ai * 128 + m * 16;
                float* dst = (row < RC) ? out + O_Y + (size_t)row * 1024 : out + O_YS + (size_t)(row - RC) * 1024;
#pragma unroll
                for (int bj = 0; bj < 2; ++bj) { const int c = c0 + bj * 32;
                    __builtin_nontemporal_store(acc[ai][bj][m][0] + xv[m][bj][0], (f32x4*)(dst + c)); __builtin_nontemporal_store(acc[ai][bj][m][1] + xv[m][bj][1], (f32x4*)(dst + c + 4)); } }
        }
    }
};

__device__ __forceinline__ void p0_transpose_item(const float* W, int K, int N, bf16_t* WT, const float* gk, LAS float* scr, int item, int lane, int kmask = 0x7fffffff, float gscale = 1.0f) {
    const int nblk = N / 32, kb = item / nblk, nb = item % nblk, k0 = 64 * kb, n0 = 32 * nb;
    { f32x4 v[8];
#pragma unroll
      for (int i = 0; i < 8; ++i) v[i] = __builtin_nontemporal_load((const f32x4*)(W + (size_t)(k0 + 8 * i + (lane >> 3)) * N + n0 + 4 * (lane & 7)));
#pragma unroll
      for (int i = 0; i < 8; ++i) { const int kk = 8 * i + (lane >> 3); const float g = gk ? gk[(k0 + kk) & kmask] * gscale : 1.0f;
#pragma unroll
          for (int j = 0; j < 4; ++j) scr[kk * 33 + 4 * (lane & 7) + j] = v[i][j] * g; } }
    asm volatile("s_waitcnt lgkmcnt(0)" ::: "memory");
    const int q = (n0 & 255) >> 5; const int n0p = (n0 & ~255) + 32 * (4 * (q & 1) + (q >> 1));
    const int c = lane & 7;
#pragma unroll
    for (int j = 0; j < 4; ++j) { const int n = (lane >> 3) + 8 * j; const LAS float* s = scr + (8 * c) * 33 + n;
        u32x4 o; o.x = cvtpk(s[0 * 33], s[1 * 33]); o.y = cvtpk(s[2 * 33], s[3 * 33]); o.z = cvtpk(s[4 * 33], s[5 * 33]); o.w = cvtpk(s[6 * 33], s[7 * 33]);
        *(u32x4*)(WT + (size_t)(n0p + n) * K + k0 + 8 * c) = o; }
    asm volatile("s_waitcnt lgkmcnt(0)" ::: "memory");
}

__device__ __forceinline__ void prologue(KArgs a, LAS unsigned char* lds, int vcu, int G) {
    const int tid = opaque_tid(), lane = tid & 63, wave = tid >> 6;
    unsigned char* ws = a->ws;
    LAS float* scr = (LAS float*)(lds + wave * 16384);
    const int gw = vcu * 8 + wave, NGW = G * 8;
    constexpr int I_IN = 16 * 208;
    for (int it = gw; it < I_IN; it += NGW) p0_transpose_item(a->in[I_WIN], 1024, NIN, (bf16_t*)(ws + WS_WIN), nullptr, scr, it, lane);
    const f32x4* gm = (const f32x4*)a->in[I_GMIX] + lane;
    bf16_t* XN = (bf16_t*)(ws + WS_XN);
    for (int row = gw; row < M1; row += NGW) {
        unsigned long long* o8 = (unsigned long long*)(XN + (size_t)row * 1024) + lane;
        if (row >= R1) {
#pragma unroll
            for (int j = 0; j < 4; ++j) o8[64 * j] = 0ull;
            continue; }
        const float* src;
        if (row < RP) { const int b = row / TP, t = row - b * TP; src = (t < NMETA) ? a->in[I_META] + (size_t)t * 1024 : a->in[I_XP] + ((size_t)b * SEQ + (t - NMETA)) * 1024; }
        else src = a->in[I_XS] + (size_t)(row - RP) * 1024;
        const f32x4* xr = (const f32x4*)src + lane;
        f32x4 v[4]; float s = 0.f;
#pragma unroll
        for (int j = 0; j < 4; ++j) { v[j] = __builtin_nontemporal_load(xr + 64 * j); s += (v[j][0] * v[j][0] + v[j][1] * v[j][1]) + (v[j][2] * v[j][2] + v[j][3] * v[j][3]); }
        const float rstd = rsqrtf(wave_sum(s) * (1.0f / 1024.0f) + EPS);
#pragma unroll
        for (int j = 0; j < 4; ++j) { const f32x4 g = gm[64 * j]; const f32x4 y = v[j] * rstd * g;
            o8[64 * j] = (unsigned long long)cvtpk(y[0], y[1]) | ((unsigned long long)cvtpk(y[2], y[3]) << 32); }
    }
    float* rope = (float*)(ws + WS_ROPE);
    for (int e = vcu * 512 + tid; e < (PAST + DS) * 8; e += G * 512) {
        const int pos = e >> 3, i = e & 7;
        const float inv = (i == 0) ? 1.0f : (i == 1) ? 0.1939227432012558f : (i == 2) ? 0.03760603070259094f : (i == 3) ? 0.007292664609849453f :
                          (i == 4) ? 0.0014142135623842478f : (i == 5) ? 0.00027424818836152554f : (i == 6) ? 5.318296098266728e-05f : 1.0313386155758053e-05f;
        const float ang = (float)pos * inv;
        double rev = (double)ang * 0.15915494309189535; rev -= floor(rev);
        const float rf = (float)rev;
        rope[pos * 16 + i] = __builtin_amdgcn_cosf(rf); rope[pos * 16 + 8 + i] = __builtin_amdgcn_sinf(rf);
    }
}

__device__ __forceinline__ void convert_late_weights(KArgs a, LAS unsigned char* lds, int idx, int n) {
    const int tid = opaque_tid(), lane = tid & 63, wave = tid >> 6;
    unsigned char* ws = a->ws;
    LAS float* scr = (LAS float*)(lds + wave * 16384);
    constexpr int I_DO = 16 * 32, I_SO = 8 * 32, I_OUT = 16 * 32, I_F1 = 16 * 128, I_F2 = 64 * 32;
    constexpr int NITEMS = I_DO + I_SO + I_OUT + I_F1 + I_F2;
    for (int it = idx * 8 + wave; it < NITEMS; it += n * 8) {
        int r = it;
        if (r < I_DO) { p0_transpose_item(a->in[I_WDO], 1024, 1024, (bf16_t*)(ws + WS_WDO), a->in[I_SUBG], scr, r, lane, 127, 1.0f - LAM_INIT); continue; } r -= I_DO;
        if (r < I_SO) { p0_transpose_item(a->in[I_WSO], 512, 1024, (bf16_t*)(ws + WS_WSO), nullptr, scr, r, lane); continue; } r -= I_SO;
        if (r < I_OUT) { p0_transpose_item(a->in[I_WOUT], 1024, 1024, (bf16_t*)(ws + WS_WOUT), nullptr, scr, r, lane); continue; } r -= I_OUT;
        if (r < I_F1) { p0_transpose_item(a->in[I_W1], 1024, DFF, (bf16_t*)(ws + WS_W1), a->in[I_GFFN], scr, r, lane); continue; } r -= I_F1;
        p0_transpose_item(a->in[I_W2], DFF, 1024, (bf16_t*)(ws + WS_W2), nullptr, scr, r, lane);
    }
}

constexpr int ATT_STAGE = 34816, ATT_VOFF = 17408, ATT_WSF = 2 * ATT_STAGE, ATT_QOFF = ATT_WSF + 2048;
#define MFMA32(a, b, c) __builtin_amdgcn_mfma_f32_32x32x16_bf16((a), (b), (c), 0, 0, 0)

__device__ __forceinline__ float rowmax32(const f32x16& p0, const f32x16& p1) {
    float a = fmaxf(p0[0], p1[0]);
#pragma unroll
    for (int r = 1; r < 16; ++r) a = fmaxf(a, fmaxf(p0[r], p1[r]));
    return fmaxf(a, __shfl_xor(a, 32));
}
__device__ __forceinline__ void packP(const f32x16& p0, const f32x16& p1, bf16x8 (&pa)[4]) {
    u32x4 w;
    w = (u32x4){cvtpk(p0[0], p0[1]), cvtpk(p0[2], p0[3]), cvtpk(p0[4], p0[5]), cvtpk(p0[6], p0[7])}; pa[0] = __builtin_bit_cast(bf16x8, w);
    w = (u32x4){cvtpk(p0[8], p0[9]), cvtpk(p0[10], p0[11]), cvtpk(p0[12], p0[13]), cvtpk(p0[14], p0[15])}; pa[1] = __builtin_bit_cast(bf16x8, w);
    w = (u32x4){cvtpk(p1[0], p1[1]), cvtpk(p1[2], p1[3]), cvtpk(p1[4], p1[5]), cvtpk(p1[6], p1[7])}; pa[2] = __builtin_bit_cast(bf16x8, w);
    w = (u32x4){cvtpk(p1[8], p1[9]), cvtpk(p1[10], p1[11]), cvtpk(p1[12], p1[13]), cvtpk(p1[14], p1[15])}; pa[3] = __builtin_bit_cast(bf16x8, w);
}

constexpr int D1_VOFF = 17408, D1_QOFF = 2 * ATT_STAGE + 2048;
__device__ __forceinline__ void diff_unit1(KArgs a, LAS unsigned char* lds, int b, int h, int qb, float lam) {
    const int tid = opaque_tid(), lane = tid & 63, r32 = lane & 31, hi = lane >> 5;
    const int wid = __builtin_amdgcn_readfirstlane(tid >> 6);
    unsigned char* ws = a->ws;
    const int rowb = b * TP;
    const int q0 = NMETA + 256 * qb + 32 * wid;
    const int jmax = 4 * qb + 4, jw = 4 * qb + (wid >> 1) + 1;
    const bf16_t* Kb = (const bf16_t*)(ws + WS_KD) + (size_t)rowb * 1024 + h * 128;
    const bf16_t* Vb = (const bf16_t*)(ws + WS_VD) + (size_t)rowb * 1024 + h * 128;
    LAS unsigned char* qlds = lds + D1_QOFF + wid * 8192 + lane * 16;
    f32x16 o[2][4];
#pragma unroll
    for (int s = 0; s < 2; ++s)
#pragma unroll
        for (int d0 = 0; d0 < 4; ++d0)
#pragma unroll
            for (int r = 0; r < 16; ++r) o[s][d0][r] = 0.f;
    float ls[2] = {0.f, 0.f};
    int never = 0; asm volatile("" : "+s"(never));
    LAS float* wsf = (LAS float*)(lds + ATT_WSF) + wid * 64;
    const int kkv = tid >> 4, kdc = tid & 15;
    const int vkp = tid & 31, vdc = tid >> 5;
    u32x4 kr[2], vr[2];
#define DA_GLOAD(j) do { \
        _Pragma("unroll") for (int i_ = 0; i_ < 2; ++i_) { int pos_ = 64 * (j) - 48 + kkv + 32 * i_; pos_ = pos_ < 0 ? 0 : pos_; kr[i_] = *(const u32x4*)(Kb + (size_t)pos_ * 1024 + kdc * 8); } \
        _Pragma("unroll") for (int i_ = 0; i_ < 2; ++i_) { int pos_ = 64 * (j) - 48 + 2 * vkp + i_; pos_ = pos_ < 0 ? 0 : pos_; vr[i_] = *(const u32x4*)(Vb + (size_t)pos_ * 1024 + vdc * 8); } } while (0)
#define DA_LSTORE(st_) do { LAS unsigned char* sb_ = lds + (st_) * ATT_STAGE; \
        _Pragma("unroll") for (int i_ = 0; i_ < 2; ++i_) *(LAS u32x4*)(sb_ + (kkv + 32 * i_) * 272 + kdc * 16) = kr[i_]; \
        _Pragma("unroll") for (int e_ = 0; e_ < 8; ++e_) { const unsigned lo_ = (vr[0][e_ >> 1] >> (16 * (e_ & 1))) & 0xffffu, hi_ = (vr[1][e_ >> 1] >> (16 * (e_ & 1))) & 0xffffu; \
            *(LAS unsigned*)(sb_ + D1_VOFF + (8 * vdc + e_) * 136 + vkp * 4) = lo_ | (hi_ << 16); } } while (0)
    DA_GLOAD(0);
    { const bf16_t* Qp = (const bf16_t*)(ws + WS_QD) + (size_t)(rowb + q0 + r32) * 1024 + h * 128 + hi * 8;
#pragma unroll
      for (int s = 0; s < 2; ++s)
#pragma unroll
          for (int d0 = 0; d0 < 4; ++d0) *(LAS bf16x8*)(qlds + (s * 4 + d0) * 1024) = *(const bf16x8*)(Qp + s * 64 + d0 * 16); }
    DA_LSTORE(0);
    __syncthreads();
    for (int j = 0; j <= jmax; ++j) {
        if (j < jmax) DA_GLOAD(j + 1);
        if (j <= jw) {
            const LAS unsigned char* Ks = lds + (j & 1) * ATT_STAGE + r32 * 272 + hi * 16;
            const LAS unsigned char* Vs = lds + (j & 1) * ATT_STAGE + D1_VOFF + r32 * 136 + hi * 8;
#pragma unroll
            for (int s = 0; s < 2; ++s) {
#pragma unroll
                for (int hf = 0; hf < 2; ++hf) {
                    if (j == 0 && hf == 0) continue;
                    f32x16 p;
#pragma unroll
                    for (int r = 0; r < 16; ++r) p[r] = 0.f;
#pragma unroll
                    for (int d0 = 0; d0 < 4; ++d0) {
                        const bf16x8 ka = *(const LAS bf16x8*)(Ks + hf * 32 * 272 + s * 128 + d0 * 32);
                        const bf16x8 qf = *(const LAS bf16x8*)(qlds + (s * 4 + d0) * 1024);
                        p = MFMA32(ka, qf, p); }
                    if (j == 0) {
#pragma unroll
                        for (int r = 0; r < 16; ++r) if (crow(r, hi) < 16) p[r] = -INFINITY; }
                    if (never) asm volatile("s_nop 0");
                    float sum = 0.f;
#pragma unroll
                    for (int r = 0; r < 16; ++r) { p[r] = ex2(p[r]); sum += p[r]; }
                    ls[s] += sum;
                    u32x4 w0 = {cvtpk(p[0], p[1]), cvtpk(p[2], p[3]), cvtpk(p[4], p[5]), cvtpk(p[6], p[7])}, w1 = {cvtpk(p[8], p[9]), cvtpk(p[10], p[11]), cvtpk(p[12], p[13]), cvtpk(p[14], p[15])};
                    const bf16x8 pa0 = __builtin_bit_cast(bf16x8, w0), pa1 = __builtin_bit_cast(bf16x8, w1);
                    {
                        const unsigned vb_ = (unsigned)(size_t)(Vs) + hf * 64;
                        const unsigned vb0 = vb_, vb1 = vb_ + 4352, vb2 = vb_ + 2 * 4352, vb3 = vb_ + 3 * 4352;
                        u32x4 fa, fb;
#define VRD(dst_, base_, k_) asm volatile("ds_read2_b64 %0, %1 offset0:%2 offset1:%3" : "=v"(dst_) : "v"(base_), "n"((k_) * 4), "n"((k_) * 4 + 2) : "memory")
#define VWT(n_, dst_) asm volatile("s_waitcnt lgkmcnt(" #n_ ")" : "+v"(dst_) :: "memory")
                        VRD(fa, vb0, 0); VRD(fb, vb0, 1);
                        VWT(1, fa); o[s][0] = MFMA32(pa0, __builtin_bit_cast(bf16x8, fa), o[s][0]); VRD(fa, vb1, 0);
                        VWT(1, fb); o[s][0] = MFMA32(pa1, __builtin_bit_cast(bf16x8, fb), o[s][0]); VRD(fb, vb1, 1);
                        VWT(1, fa); o[s][1] = MFMA32(pa0, __builtin_bit_cast(bf16x8, fa), o[s][1]); VRD(fa, vb2, 0);
                        VWT(1, fb); o[s][1] = MFMA32(pa1, __builtin_bit_cast(bf16x8, fb), o[s][1]); VRD(fb, vb2, 1);
                        VWT(1, fa); o[s][2] = MFMA32(pa0, __builtin_bit_cast(bf16x8, fa), o[s][2]); VRD(fa, vb3, 0);
                        VWT(1, fb); o[s][2] = MFMA32(pa1, __builtin_bit_cast(bf16x8, fb), o[s][2]); VRD(fb, vb3, 1);
                        VWT(1, fa); o[s][3] = MFMA32(pa0, __builtin_bit_cast(bf16x8, fa), o[s][3]);
                        VWT(0, fb); o[s][3] = MFMA32(pa1, __builtin_bit_cast(bf16x8, fb), o[s][3]);
#undef VRD
#undef VWT
                    }
                }
            }
        }
        if (j < jmax) DA_LSTORE((j + 1) & 1);
        __syncthreads();
    }
#undef DA_GLOAD
#undef DA_LSTORE
    ls[0] += __shfl_xor(ls[0], 32); ls[1] += __shfl_xor(ls[1], 32);
    if (hi == 0) { wsf[r32] = 1.0f / ls[0]; wsf[32 + r32] = lam / ls[1]; }
    bf16_t* Od = (bf16_t*)(ws + WS_OD) + (size_t)(b * SEQ + 256 * qb + 32 * wid) * 1024 + h * 128 + r32;
#pragma unroll
    for (int r = 0; r < 16; ++r) {
        const float f1 = wsf[crow(r, hi)], f2 = wsf[32 + crow(r, hi)];
        float v[4]; float ss = 0.f;
#pragma unroll
        for (int d0 = 0; d0 < 4; ++d0) { v[d0] = o[0][d0][r] * f1 - o[1][d0][r] * f2; ss += v[d0] * v[d0]; }
#pragma unroll
        for (int off = 1; off < 32; off <<= 1) ss += __shfl_xor(ss, off);
        const float rstd = rsqrtf(ss * (1.0f / 128.0f) + EPS);
#pragma unroll
        for (int d0 = 0; d0 < 4; ++d0) Od[(size_t)crow(r, hi) * 1024 + 32 * d0] = (bf16_t)(cvtpk(v[d0] * rstd, 0.f) & 0xffffu);
    }
}

__device__ __forceinline__ void sb_weights(f32x16& z0, f32x16& z1, float& R, int hi) {
    f32x16 s0, s1;
#pragma unroll
    for (int r = 0; r < 16; ++r) { z0[r] = ex2(z0[r]); z1[r] = ex2(z1[r]); s0[r] = __builtin_amdgcn_rcpf(1.0f + z0[r]); s1[r] = __builtin_amdgcn_rcpf(1.0f + z1[r]); }
    float gs[8], pg[8], off[8];
#pragma unroll
    for (int g = 0; g < 4; ++g) { gs[g] = (s0[4 * g] * s0[4 * g + 1]) * (s0[4 * g + 2] * s0[4 * g + 3]); gs[4 + g] = (s1[4 * g] * s1[4 * g + 1]) * (s1[4 * g + 2] * s1[4 * g + 3]); }
#pragma unroll
    for (int g = 0; g < 8; ++g) pg[g] = __shfl_xor(gs[g], 32);
    float run = ex2(-R);
#pragma unroll
    for (int g = 7; g >= 0; --g) { off[g] = run * (hi == 0 ? pg[g] : 1.0f); run *= gs[g] * pg[g]; }
    float tp = 1.0f;
#pragma unroll
    for (int g = 0; g < 8; ++g) tp *= gs[g] * pg[g];
    R -= lg2(tp);
#pragma unroll
    for (int g = 0; g < 4; ++g) {
        float c = off[g];
#pragma unroll
        for (int e = 3; e >= 0; --e) { c *= s0[4 * g + e]; z0[4 * g + e] *= c; }
        c = off[4 + g];
#pragma unroll
        for (int e = 3; e >= 0; --e) { c *= s1[4 * g + e]; z1[4 * g + e] *= c; }
    }
}

constexpr int SB_VOFF = 9216;
__device__ __forceinline__ void sb_unit(KArgs a, LAS unsigned char* lds, int b, int h, int qb) {
    const int tid = opaque_tid(), lane = tid & 63, r32 = lane & 31, hi = lane >> 5;
    const int wid = __builtin_amdgcn_readfirstlane(tid >> 6);
    unsigned char* ws = a->ws;
    const int rowb = b * TP;
    const int q0 = NMETA + 256 * qb + 32 * wid;
    const int jmax = 4 * qb + 4, jw = 4 * qb + (wid >> 1) + 1;
    const bf16_t* Kb = (const bf16_t*)(ws + WS_KS) + (size_t)rowb * 512 + h * 64;
    const bf16_t* Vb = (const bf16_t*)(ws + WS_VS) + (size_t)rowb * 512 + h * 64;
    bf16x8 q[4];
    { const bf16_t* Qp = (const bf16_t*)(ws + WS_QS) + (size_t)(rowb + q0 + r32) * 512 + h * 64 + hi * 8;
#pragma unroll
      for (int d0 = 0; d0 < 4; ++d0) q[d0] = *(const bf16x8*)(Qp + d0 * 16); }
    f32x16 o[2];
#pragma unroll
    for (int d0 = 0; d0 < 2; ++d0)
#pragma unroll
        for (int r = 0; r < 16; ++r) o[d0][r] = 0.f;
    float R = 0.f;
    const int kkv = tid >> 3, kdc = tid & 7;
    const int vkp = tid & 31, vdc = (tid >> 5) & 7;
    u32x4 kr, vr[2];
#define SB_GLOAD(j) do { \
        { int pos_ = 64 * (j) - 48 + kkv; pos_ = pos_ < 0 ? 0 : pos_; kr = *(const u32x4*)(Kb + (size_t)pos_ * 512 + kdc * 8); } \
        if (tid < 256) { _Pragma("unroll") for (int i_ = 0; i_ < 2; ++i_) { int pos_ = 64 * (j) - 48 + 2 * vkp + i_; pos_ = pos_ < 0 ? 0 : pos_; vr[i_] = *(const u32x4*)(Vb + (size_t)pos_ * 512 + vdc * 8); } } } while (0)
#define SB_LSTORE(s) do { LAS unsigned char* sb_ = lds + (s) * ATT_STAGE; \
        *(LAS u32x4*)(sb_ + kkv * 144 + kdc * 16) = kr; \
        if (tid < 256) { _Pragma("unroll") for (int e_ = 0; e_ < 8; ++e_) { const unsigned lo_ = (vr[0][e_ >> 1] >> (16 * (e_ & 1))) & 0xffffu, hi_ = (vr[1][e_ >> 1] >> (16 * (e_ & 1))) & 0xffffu; \
            *(LAS unsigned*)(sb_ + SB_VOFF + (8 * vdc + e_) * 136 + vkp * 4) = lo_ | (hi_ << 16); } } } while (0)
    SB_GLOAD(jmax); SB_LSTORE(0);
    __syncthreads();
    int st = 0;
    for (int j = jmax; j >= 0; --j) {
        if (j > 0) SB_GLOAD(j - 1);
        if (j <= jw) {
            const LAS unsigned char* Ks = lds + st * ATT_STAGE + r32 * 144 + hi * 16;
            const LAS unsigned char* Vs = lds + st * ATT_STAGE + SB_VOFF + r32 * 136 + hi * 8;
            f32x16 p0, p1;
#pragma unroll
            for (int r = 0; r < 16; ++r) { p0[r] = 0.f; p1[r] = 0.f; }
#pragma unroll
            for (int d0 = 0; d0 < 4; ++d0) {
                const bf16x8 ka = *(const LAS bf16x8*)(Ks + d0 * 32), kb = *(const LAS bf16x8*)(Ks + 32 * 144 + d0 * 32);
                p0 = MFMA32(ka, q[d0], p0); p1 = MFMA32(kb, q[d0], p1); }
            if (j == jw) { const int qrel = 32 * (wid & 1) + r32; asm volatile("" ::: "memory");
#pragma unroll
                for (int r = 0; r < 16; ++r) { if (crow(r, hi) >= qrel) p0[r] = -INFINITY; if (crow(r, hi) + 32 >= qrel) p1[r] = -INFINITY; } }
            if (j == 0) { asm volatile("" ::: "memory");
#pragma unroll
                for (int r = 0; r < 16; ++r) { p0[r] = -INFINITY; if (crow(r, hi) < 16) p1[r] = -INFINITY; } }
            sb_weights(p0, p1, R, hi);
            bf16x8 pa[4]; packP(p0, p1, pa);
            {
                const unsigned vb0 = (unsigned)(size_t)(Vs), vb1 = vb0 + 4352;
                u32x4 fa, fb;
#define VRD(dst_, base_, k_) asm volatile("ds_read2_b64 %0, %1 offset0:%2 offset1:%3" : "=v"(dst_) : "v"(base_), "n"((k_) * 4), "n"((k_) * 4 + 2) : "memory")
#define VWT(n_, dst_) asm volatile("s_waitcnt lgkmcnt(" #n_ ")" : "+v"(dst_) :: "memory")
                VRD(fa, vb0, 0); VRD(fb, vb0, 1);
                VWT(1, fa); o[0] = MFMA32(pa[0], __builtin_bit_cast(bf16x8, fa), o[0]); VRD(fa, vb0, 2);
                VWT(1, fb); o[0] = MFMA32(pa[1], __builtin_bit_cast(bf16x8, fb), o[0]); VRD(fb, vb0, 3);
                VWT(1, fa); o[0] = MFMA32(pa[2], __builtin_bit_cast(bf16x8, fa), o[0]); VRD(fa, vb1, 0);
                VWT(1, fb); o[0] = MFMA32(pa[3], __builtin_bit_cast(bf16x8, fb), o[0]); VRD(fb, vb1, 1);
                VWT(1, fa); o[1] = MFMA32(pa[0], __builtin_bit_cast(bf16x8, fa), o[1]); VRD(fa, vb1, 2);
                VWT(1, fb); o[1] = MFMA32(pa[1], __builtin_bit_cast(bf16x8, fb), o[1]); VRD(fb, vb1, 3);
                VWT(1, fa); o[1] = MFMA32(pa[2], __builtin_bit_cast(bf16x8, fa), o[1]);
                VWT(0, fb); o[1] = MFMA32(pa[3], __builtin_bit_cast(bf16x8, fb), o[1]);
#undef VRD
#undef VWT
            }
        }
        if (j > 0) SB_LSTORE(st ^ 1);
        __syncthreads();
        st ^= 1;
    }
#undef SB_GLOAD
#undef SB_LSTORE
    LAS bf16_t* stg = (LAS bf16_t*)(lds + wid * 4608);
#pragma unroll
    for (int r = 0; r < 16; ++r)
#pragma unroll
        for (int d0 = 0; d0 < 2; ++d0) stg[crow(r, hi) * 72 + 32 * d0 + r32] = (bf16_t)(cvtpk(o[d0][r], 0.f) & 0xffffu);
    bf16_t* Os = (bf16_t*)(ws + WS_OS) + (size_t)(b * SEQ + 256 * qb + 32 * wid) * 512 + h * 64;
#pragma unroll
    for (int i = 0; i < 4; ++i) { const int row = 8 * i + (lane >> 3), ch = lane & 7;
        *(u32x4*)(Os + (size_t)row * 512 + 8 * ch) = *(const LAS u32x4*)(stg + row * 72 + 8 * ch); }
    __syncthreads();
}

__device__ __forceinline__ bf16x8 ld8f(const float* p) { const f32x4 a = __builtin_nontemporal_load((const f32x4*)p), b = __builtin_nontemporal_load((const f32x4*)(p + 4));
    const u32x4 w = {cvtpk(a[0], a[1]), cvtpk(a[2], a[3]), cvtpk(b[0], b[1]), cvtpk(b[2], b[3])}; return __builtin_bit_cast(bf16x8, w); }

__device__ __forceinline__ void sample_unit(KArgs a, LAS unsigned char* lds, int b, int h, int split) {
    const int tid = opaque_tid(), lane = tid & 63, r32 = lane & 31, hi = lane >> 5;
    const int wid = __builtin_amdgcn_readfirstlane(tid >> 6);
    unsigned char* ws = a->ws;
    const int nt = 2;
    const int kbase = split * 1024 + wid * 128;
    const int srow = RP + b * DS;
    float* part = (float*)(ws + WS_PART) + (size_t)((b * 8 + h) * 4 + split) * PART_FLOATS;
    LAS float* wsf = (LAS float*)(lds + 65536) + wid * 64;
    LAS float* accs = (LAS float*)lds;
    LAS float* stat = (LAS float*)(lds + 32768);
    const unsigned koffL = (unsigned)(r32 * 1024 + hi * 8);
    const unsigned voffL4 = (unsigned)(4 * hi * 1024 + 4 * r32);
    int one_ = 1; asm volatile("" : "+s"(one_));
    for (int it_ = 0; it_ < one_; ++it_) { const int s = wid & 1; const int kb4 = split * 1024 + (wid >> 1) * 256;
        bf16x8 q[4];
        { const bf16_t* Qp = (const bf16_t*)(ws + WS_QD) + (size_t)(srow + r32) * 1024 + h * 128 + s * 64 + hi * 8;
#pragma unroll
          for (int d0 = 0; d0 < 4; ++d0) q[d0] = *(const bf16x8*)(Qp + d0 * 16); }
        f32x16 o[4];
#pragma unroll
        for (int d0 = 0; d0 < 4; ++d0)
#pragma unroll
            for (int r = 0; r < 16; ++r) o[d0][r] = 0.f;
        float mx = -INFINITY, ls = 0.f;
        for (int t = 3; t >= 0; --t) {
            const bool isnew = false;
            const float* kt = (isnew ? a->out + O_SDK + (size_t)(b * DS) * 1024 + h * 128 : a->in[I_CDK] + ((size_t)(b * PAST + kb4 + 64 * t) * 8 + h) * 128) + s * 64;
            const float* vt = isnew ? a->out + O_SDV + (size_t)(b * DS) * 1024 + h * 128 : a->in[I_CDV] + ((size_t)(b * PAST + kb4 + 64 * t) * 8 + h) * 128;
            f32x16 p0, p1;
#pragma unroll
            for (int r = 0; r < 16; ++r) { p0[r] = 0.f; p1[r] = 0.f; }
            { bf16x8 ka[4], kb[4];
#pragma unroll
              for (int d0 = 0; d0 < 4; ++d0) { ka[d0] = ld8f(kt + d0 * 16 + koffL); kb[d0] = ld8f(kt + 32 * 1024 + d0 * 16 + koffL); }
#pragma unroll
              for (int d0 = 0; d0 < 4; ++d0) { p0 = MFMA32(ka[d0], q[d0], p0); p1 = MFMA32(kb[d0], q[d0], p1); } }
            if (isnew) {
#pragma unroll
                for (int r = 0; r < 16; ++r) p1[r] = -INFINITY; }
            const float rm = rowmax32(p0, p1);
            if (__any(rm > mx + 8.0f)) {
                const float mn = fmaxf(mx, rm); const float f = ex2(mx - mn); mx = mn; ls *= f;
                if (hi == 0) wsf[r32] = f;
#pragma unroll
                for (int r = 0; r < 16; ++r) { const float fr_ = wsf[crow(r, hi)];
#pragma unroll
                    for (int d0 = 0; d0 < 4; ++d0) o[d0][r] *= fr_; }
            }
            float sum = 0.f;
#pragma unroll
            for (int r = 0; r < 16; ++r) { p0[r] = ex2(p0[r] - mx); p1[r] = ex2(p1[r] - mx); sum += p0[r] + p1[r]; }
            ls += sum;
            bf16x8 pa[4]; packP(p0, p1, pa);
#pragma unroll
            for (int kp = 0; kp < 2; ++kp) {
                if (isnew && kp == 1) break;
                f32x4 v[2][8];
#pragma unroll
                for (int k2 = 0; k2 < 2; ++k2)
#pragma unroll
                    for (int e = 0; e < 8; ++e) v[k2][e] = __builtin_nontemporal_load((const f32x4*)(vt + (16 * (2 * kp + k2) + (e & 3) + 8 * (e >> 2)) * 1024 + voffL4));
#pragma unroll
                for (int k2 = 0; k2 < 2; ++k2)
#pragma unroll
                    for (int d0 = 0; d0 < 4; ++d0) { float t[8];
#pragma unroll
                        for (int e = 0; e < 8; ++e) t[e] = v[k2][e][d0];
                        const u32x4 vv = pack8(t); o[d0] = MFMA32(pa[2 * kp + k2], __builtin_bit_cast(bf16x8, vv), o[d0]); }
            }
        }
        ls += __shfl_xor(ls, 32);
        if (hi == 0) stat[wid * 32 + r32] = mx;
        __syncthreads();
        float mb = stat[s * 32 + r32];
#pragma unroll
        for (int j = 1; j < 4; ++j) mb = fmaxf(mb, stat[(2 * j + s) * 32 + r32]);
        const float fw = ex2(mx - mb);
        if (hi == 0) wsf[r32] = fw;
        LAS float* lacc = stat + 512;
        for (int w = 0; w < 4; ++w) {
            if ((wid >> 1) == w) {
#pragma unroll
                for (int r = 0; r < 16; ++r) { const int qq = crow(r, hi); const float f = wsf[qq];
#pragma unroll
                    for (int d0 = 0; d0 < 4; ++d0) { LAS float* p = accs + (s * 32 + qq) * 128 + 4 * r32 + d0; const float v = o[d0][r] * f; *p = (w == 0) ? v : *p + v; } }
                if (hi == 0) { LAS float* p = lacc + s * 32 + r32; const float v = ls * fw; *p = (w == 0) ? v : *p + v; }
            }
            __syncthreads();
        }
        if (wid < 2 && hi == 0) { part[s * 64 + r32] = mb; part[s * 64 + 32 + r32] = lacc[s * 32 + r32]; }
    }
    for (int i = tid; i < 2048; i += 512) *(f32x4*)(part + 128 + 4 * i) = *(const LAS f32x4*)(accs + 4 * i);
    __syncthreads();
    {
        bf16x8 q[4];
        { const bf16_t* Qp = (const bf16_t*)(ws + WS_QS) + (size_t)(srow + r32) * 512 + h * 64 + hi * 8;
#pragma unroll
          for (int d0 = 0; d0 < 4; ++d0) q[d0] = *(const bf16x8*)(Qp + d0 * 16); }
        f32x16 o[2];
#pragma unroll
        for (int d0 = 0; d0 < 2; ++d0)
#pragma unroll
            for (int r = 0; r < 16; ++r) o[d0][r] = 0.f;
        float R = 0.f;
        const unsigned koffS = (unsigned)(r32 * 512 + hi * 8), voffS2 = (unsigned)(4 * hi * 512 + 2 * r32);
        for (int t = nt - 1; t >= 0; --t) {
            asm volatile("" ::: "memory");
            const bool isnew = (t == 2);
            const float* kt = isnew ? a->out + O_SSK + (size_t)(b * DS) * 512 + h * 64 : a->in[I_CSK] + ((size_t)(b * PAST + kbase + 64 * t) * 8 + h) * 64;
            const float* vt = isnew ? a->out + O_SSV + (size_t)(b * DS) * 512 + h * 64 : a->in[I_CSV] + ((size_t)(b * PAST + kbase + 64 * t) * 8 + h) * 64;
            f32x16 p0, p1;
#pragma unroll
            for (int r = 0; r < 16; ++r) { p0[r] = 0.f; p1[r] = 0.f; }
            { bf16x8 ka[4], kb[4];
#pragma unroll
              for (int d0 = 0; d0 < 4; ++d0) { ka[d0] = ld8f(kt + d0 * 16 + koffS); kb[d0] = ld8f(kt + 32 * 512 + d0 * 16 + koffS); }
#pragma unroll
              for (int d0 = 0; d0 < 4; ++d0) { p0 = MFMA32(ka[d0], q[d0], p0); p1 = MFMA32(kb[d0], q[d0], p1); } }
            if (isnew) {
#pragma unroll
                for (int r = 0; r < 16; ++r) { p1[r] = -INFINITY; if (crow(r, hi) >= r32) p0[r] = -INFINITY; } }
            sb_weights(p0, p1, R, hi);
            bf16x8 pa[4]; packP(p0, p1, pa);
            {
                f32x2_t v[4][8];
#pragma unroll
                for (int ks = 0; ks < 4; ++ks)
#pragma unroll
                    for (int e = 0; e < 8; ++e) v[ks][e] = (isnew && ks >= 2) ? (f32x2_t){0.f, 0.f} : __builtin_nontemporal_load((const f32x2_t*)(vt + (16 * ks + (e & 3) + 8 * (e >> 2)) * 512 + voffS2));
#pragma unroll
                for (int ks = 0; ks < 4; ++ks)
#pragma unroll
                    for (int d0 = 0; d0 < 2; ++d0) { float t[8];
#pragma unroll
                        for (int e = 0; e < 8; ++e) t[e] = v[ks][e][d0];
                        const u32x4 vv = pack8(t); o[d0] = MFMA32(pa[ks], __builtin_bit_cast(bf16x8, vv), o[d0]); }
            }
        }
        if (hi == 0) stat[wid * 32 + r32] = R;
        __syncthreads();
        float offs = 0.f, tot = 0.f;
#pragma unroll
        for (int w = 0; w < 8; ++w) { const float t_ = stat[w * 32 + r32]; tot += t_; if (w > wid) offs += t_; }
        if (hi == 0) wsf[r32] = ex2(-offs);
        for (int w = 0; w < 8; ++w) {
            if (wid == w) {
#pragma unroll
                for (int r = 0; r < 16; ++r) { const int qq = crow(r, hi); const float f = wsf[qq];
#pragma unroll
                    for (int d0 = 0; d0 < 2; ++d0) { LAS float* p = accs + qq * 64 + 2 * r32 + d0; const float v = o[d0][r] * f; *p = (w == 0) ? v : *p + v; } }
            }
            __syncthreads();
        }
        if (tid < 32) part[8320 + tid] = tot;
        { const int i = tid; *(f32x4*)(part + 8352 + 4 * i) = *(const LAS f32x4*)(accs + 4 * i); }
        __syncthreads();
    }
}

__device__ __forceinline__ void sample_combine(KArgs a, LAS unsigned char* lds, int b, int h, float lam) {
    const int tid = opaque_tid(), lane = tid & 63, r32 = lane & 31, hi = lane >> 5;
    const int wid = __builtin_amdgcn_readfirstlane(tid >> 6);
    unsigned char* ws = a->ws;
    const float* part = (const float*)(ws + WS_PART) + (size_t)((b * 8 + h) * 4) * PART_FLOATS;
    LAS float* np = (LAS float*)lds;
    const int srow = RP + b * DS;
    if (wid == 0) {
#pragma unroll
        for (int s = 0; s < 2; ++s) {
            f32x16 p;
#pragma unroll
            for (int r = 0; r < 16; ++r) p[r] = 0.f;
            { const bf16_t* kp = (const bf16_t*)(ws + WS_KD) + (size_t)(srow + r32) * 1024 + h * 128 + s * 64 + hi * 8;
              const bf16_t* qp = (const bf16_t*)(ws + WS_QD) + (size_t)(srow + r32) * 1024 + h * 128 + s * 64 + hi * 8;
#pragma unroll
              for (int d0 = 0; d0 < 4; ++d0) p = MFMA32(*(const bf16x8*)(kp + d0 * 16), *(const bf16x8*)(qp + d0 * 16), p); }
            float m = fmaxf(p[0], p[1]);
#pragma unroll
            for (int r = 2; r < 16; ++r) m = fmaxf(m, p[r]);
            m = fmaxf(m, __shfl_xor(m, 32));
            float l = 0.f;
#pragma unroll
            for (int r = 0; r < 16; ++r) { p[r] = ex2(p[r] - m); l += p[r]; }
            l += __shfl_xor(l, 32);
            const u32x4 w0 = {cvtpk(p[0], p[1]), cvtpk(p[2], p[3]), cvtpk(p[4], p[5]), cvtpk(p[6], p[7])}, w1 = {cvtpk(p[8], p[9]), cvtpk(p[10], p[11]), cvtpk(p[12], p[13]), cvtpk(p[14], p[15])};
            const bf16_t* vp = (const bf16_t*)(ws + WS_VD) + (size_t)(srow + 4 * hi) * 1024 + h * 128 + r32;
#pragma unroll
            for (int d0 = 0; d0 < 4; ++d0) {
                f32x16 o;
#pragma unroll
                for (int r = 0; r < 16; ++r) o[r] = 0.f;
#pragma unroll
                for (int ks = 0; ks < 2; ++ks) { unsigned w[4];
#pragma unroll
                    for (int e2 = 0; e2 < 4; ++e2) { const int e = 2 * e2;
                        const unsigned lo = vp[(size_t)(16 * ks + (e & 3) + 8 * (e >> 2)) * 1024 + 32 * d0], hi_ = vp[(size_t)(16 * ks + ((e + 1) & 3) + 8 * ((e + 1) >> 2)) * 1024 + 32 * d0]; w[e2] = lo | (hi_ << 16); }
                    const u32x4 vv = {w[0], w[1], w[2], w[3]};
                    o = MFMA32(__builtin_bit_cast(bf16x8, ks ? w1 : w0), __builtin_bit_cast(bf16x8, vv), o); }
#pragma unroll
                for (int r = 0; r < 16; ++r) np[128 + (s * 32 + crow(r, hi)) * 128 + 32 * d0 + r32] = o[r];
            }
            if (hi == 0) { np[s * 64 + r32] = m; np[s * 64 + 32 + r32] = l; }
        }
        {
            f32x16 p0, p1;
#pragma unroll
            for (int r = 0; r < 16; ++r) { p0[r] = 0.f; p1[r] = -INFINITY; }
            { const bf16_t* kp = (const bf16_t*)(ws + WS_KS) + (size_t)(srow + r32) * 512 + h * 64 + hi * 8;
              const bf16_t* qp = (const bf16_t*)(ws + WS_QS) + (size_t)(srow + r32) * 512 + h * 64 + hi * 8;
#pragma unroll
              for (int d0 = 0; d0 < 4; ++d0) p0 = MFMA32(*(const bf16x8*)(kp + d0 * 16), *(const bf16x8*)(qp + d0 * 16), p0); }
#pragma unroll
            for (int r = 0; r < 16; ++r) if (crow(r, hi) >= r32) p0[r] = -INFINITY;
            float R = 0.f;
            sb_weights(p0, p1, R, hi);
            const u32x4 w0 = {cvtpk(p0[0], p0[1]), cvtpk(p0[2], p0[3]), cvtpk(p0[4], p0[5]), cvtpk(p0[6], p0[7])}, w1 = {cvtpk(p0[8], p0[9]), cvtpk(p0[10], p0[11]), cvtpk(p0[12], p0[13]), cvtpk(p0[14], p0[15])};
            const bf16_t* vp = (const bf16_t*)(ws + WS_VS) + (size_t)(srow + 4 * hi) * 512 + h * 64 + r32;
#pragma unroll
            for (int d0 = 0; d0 < 2; ++d0) {
                f32x16 o;
#pragma unroll
                for (int r = 0; r < 16; ++r) o[r] = 0.f;
#pragma unroll
                for (int ks = 0; ks < 2; ++ks) { unsigned w[4];
#pragma unroll
                    for (int e2 = 0; e2 < 4; ++e2) { const int e = 2 * e2;
                        const unsigned lo = vp[(size_t)(16 * ks + (e & 3) + 8 * (e >> 2)) * 512 + 32 * d0], hi_ = vp[(size_t)(16 * ks + ((e + 1) & 3) + 8 * ((e + 1) >> 2)) * 512 + 32 * d0]; w[e2] = lo | (hi_ << 16); }
                    const u32x4 vv = {w[0], w[1], w[2], w[3]};
                    o = MFMA32(__builtin_bit_cast(bf16x8, ks ? w1 : w0), __builtin_bit_cast(bf16x8, vv), o); }
#pragma unroll
                for (int r = 0; r < 16; ++r) np[8352 + crow(r, hi) * 64 + 32 * d0 + r32] = o[r];
            }
            if (hi == 0) np[8320 + r32] = R;
        }
    }
    __syncthreads();
    {
        const int qq = tid >> 4, c = tid & 15;
        float v[2][8];
#pragma unroll
        for (int s = 0; s < 2; ++s) {
            float m[5], l[5], M = -INFINITY;
#pragma unroll
            for (int sp = 0; sp < 4; ++sp) { m[sp] = part[sp * PART_FLOATS + s * 64 + qq]; l[sp] = part[sp * PART_FLOATS + s * 64 + 32 + qq]; M = fmaxf(M, m[sp]); }
            m[4] = np[s * 64 + qq]; l[4] = np[s * 64 + 32 + qq]; M = fmaxf(M, m[4]);
            float L = 0.f;
#pragma unroll
            for (int i = 0; i < 8; ++i) v[s][i] = 0.f;
#pragma unroll
            for (int sp = 0; sp < 5; ++sp) { const float f = ex2(m[sp] - M); L += l[sp] * f;
                f32x4 x0, x1;
                if (sp < 4) { const float* op = part + sp * PART_FLOATS + 128 + (s * 32 + qq) * 128 + 8 * c; x0 = *(const f32x4*)op; x1 = *(const f32x4*)(op + 4); }
                else { const LAS float* op = np + 128 + (s * 32 + qq) * 128 + 8 * c; x0 = *(const LAS f32x4*)op; x1 = *(const LAS f32x4*)(op + 4); }
#pragma unroll
                for (int i = 0; i < 4; ++i) { v[s][i] += x0[i] * f; v[s][4 + i] += x1[i] * f; } }
            const float inv = 1.0f / L;
#pragma unroll
            for (int i = 0; i < 8; ++i) v[s][i] *= inv;
        }
        float y[8]; float ss = 0.f;
#pragma unroll
        for (int i = 0; i < 8; ++i) { y[i] = v[0][i] - lam * v[1][i]; ss += y[i] * y[i]; }
#pragma unroll
        for (int off = 1; off < 16; off <<= 1) ss += __shfl_xor(ss, off);
        const float rstd = rsqrtf(ss * (1.0f / 128.0f) + EPS);
#pragma unroll
        for (int i = 0; i < 8; ++i) y[i] *= rstd;
        *(u32x4*)((bf16_t*)(ws + WS_OD) + (size_t)(RC + b * DS + qq) * 1024 + h * 128 + 8 * c) = pack8(y);
    }
    if (tid < 256) {
        const int qq = tid >> 3, c = tid & 7;
        float y[8];
        { const LAS float* op = np + 8352 + qq * 64 + 8 * c; const f32x4 x0 = *(const LAS f32x4*)op, x1 = *(const LAS f32x4*)(op + 4);
#pragma unroll
          for (int i = 0; i < 4; ++i) { y[i] = x0[i]; y[4 + i] = x1[i]; } }
        float offs = np[8320 + qq];
#pragma unroll
        for (int sp = 3; sp >= 0; --sp) { const float f = ex2(-offs);
            const float* op = part + sp * PART_FLOATS + 8352 + qq * 64 + 8 * c; const f32x4 x0 = *(const f32x4*)op, x1 = *(const f32x4*)(op + 4);
#pragma unroll
            for (int i = 0; i < 4; ++i) { y[i] += x0[i] * f; y[4 + i] += x1[i] * f; }
            offs += part[sp * PART_FLOATS + 8320 + qq]; }
        *(u32x4*)((bf16_t*)(ws + WS_OS) + (size_t)(RC + b * DS + qq) * 512 + h * 64 + 8 * c) = pack8(y);
    }
    __syncthreads();
}

__device__ __forceinline__ int phys_row0(int cb) { const int q = cb & 7; return (cb >> 3) * 256 + 32 * (4 * (q & 1) + (q >> 1)); }
__device__ __forceinline__ void skinny_acc(f32x16& acc, const bf16_t* A, const bf16_t* Bt, int K, int row0, int prow0, int wid, int r32, int hi) {
    const int kw = K >> 3;
    const bf16_t* ap = A + (size_t)(row0 + r32) * K + wid * kw + hi * 8;
    const bf16_t* bp = Bt + (size_t)(prow0 + r32) * K + wid * kw + hi * 8;
#pragma unroll 8
    for (int k = 0; k < kw; k += 16) { const bf16x8 av = *(const bf16x8*)(ap + k), bv = *(const bf16x8*)(bp + k); acc = MFMA32(av, bv, acc); }
}
__device__ __forceinline__ void skinny_acc2(f32x16& acc, f32x16& acc2, const bf16_t* A, const bf16_t* Bt, int K, int row0, int prow0, int prow1, int wid, int r32, int hi) {
    const int kw = K >> 3;
    const bf16_t* ap = A + (size_t)(row0 + r32) * K + wid * kw + hi * 8;
    const bf16_t* bp = Bt + (size_t)(prow0 + r32) * K + wid * kw + hi * 8;
    const bf16_t* bq = Bt + (size_t)(prow1 + r32) * K + wid * kw + hi * 8;
#pragma unroll 8
    for (int k = 0; k < kw; k += 16) { const bf16x8 av = *(const bf16x8*)(ap + k), bv = *(const bf16x8*)(bp + k), bw = *(const bf16x8*)(bq + k); acc = MFMA32(av, bv, acc); acc2 = MFMA32(av, bw, acc2); }
}
__device__ __forceinline__ void skinny_put(LAS float* red, const f32x16& acc, int wid, int r32, int hi) {
#pragma unroll
    for (int r = 0; r < 16; ++r) red[(wid * 32 + crow(r, hi)) * 33 + r32] = acc[r];
}
__device__ __forceinline__ void skinny_get(const LAS float* red, int row, int col, float& s0, float& s1) {
    s0 = 0.f; s1 = 0.f;
#pragma unroll
    for (int w = 0; w < 8; ++w) { s0 += red[(w * 32 + row) * 33 + col]; s1 += red[(w * 32 + row) * 33 + col + 1]; }
}
constexpr size_t WS_SSS = WS_SS + 1280 * 1024;
__device__ __forceinline__ void skinny_phase(KArgs a, LAS unsigned char* lds, int which, int vcu, int G) {
    const int tid = opaque_tid(), lane = tid & 63, r32 = lane & 31, hi = lane >> 5;
    const int wid = __builtin_amdgcn_readfirstlane(tid >> 6);
    unsigned char* ws = a->ws;
    LAS float* red = (LAS float*)lds; LAS float* red2 = (LAS float*)(lds + 34816);
    const int row = tid >> 4, col = 2 * (tid & 15);
    const int nunits = (which == 2) ? 512 : 256;
    for (int u = vcu; u < nunits; u += G) {
        const int rb = u & 7; int cb = (which == 2) ? 2 * (u >> 3) : (u >> 3);
        const int row0 = RC + 32 * rb, prow0 = phys_row0(cb);
        const int grow = row0 + row, srow = grow - RC; int gcol = 32 * cb + col;
        f32x16 acc, acc2;
#pragma unroll
        for (int r = 0; r < 16; ++r) { acc[r] = 0.f; acc2[r] = 0.f; }
        if (which == 0) {
            skinny_acc(acc, (const bf16_t*)(ws + WS_OD), (const bf16_t*)(ws + WS_WDO), 1024, row0, prow0, wid, r32, hi);
            skinny_acc(acc2, (const bf16_t*)(ws + WS_OS), (const bf16_t*)(ws + WS_WSO), 512, row0, prow0, wid, r32, hi);
            skinny_put(red, acc, wid, r32, hi); skinny_put(red2, acc2, wid, r32, hi);
        } else if (which == 1) {
            skinny_acc(acc, (const bf16_t*)(ws + WS_XN), (const bf16_t*)(ws + WS_WOUT), 1024, row0, prow0, wid, r32, hi);
            skinny_put(red, acc, wid, r32, hi);
        } else if (which == 2) {
            skinny_acc2(acc, acc2, (const bf16_t*)(ws + WS_OD), (const bf16_t*)(ws + WS_W1), 1024, row0, prow0, phys_row0(cb + 1), wid, r32, hi);
            skinny_put(red, acc, wid, r32, hi); skinny_put(red2, acc2, wid, r32, hi);
        } else {
            skinny_acc(acc, (const bf16_t*)(ws + WS_H), (const bf16_t*)(ws + WS_W2), 4096, row0, prow0, wid, r32, hi);
            skinny_put(red, acc, wid, r32, hi);
        }
        __syncthreads();
        float s0, s1; skinny_get(red, row, col, s0, s1);
        if (which == 0) {
            float t0, t1; skinny_get(red2, row, col, t0, t1);
            const unsigned gd = *(const unsigned*)((const bf16_t*)(ws + WS_G) + (size_t)grow * 2048 + gcol), gs = *(const unsigned*)((const bf16_t*)(ws + WS_G) + (size_t)grow * 2048 + 1024 + gcol);
            *(unsigned*)((bf16_t*)(ws + WS_XN) + (size_t)grow * 1024 + gcol) = cvtpk(bf_lo(gd) * s0 + bf_lo(gs) * t0, bf_hi(gd) * s1 + bf_hi(gs) * t1);
        } else if (which == 1) {
            const float* xr = a->in[I_XS] + (size_t)srow * 1024 + gcol;
            const float v0 = xr[0] + s0, v1 = xr[1] + s1;
            *(f32x2_t*)((float*)(ws + WS_G) + (size_t)grow * 1024 + gcol) = (f32x2_t){v0, v1};
            *(unsigned*)((bf16_t*)(ws + WS_OD) + (size_t)grow * 1024 + gcol) = cvtpk(v0, v1);
            float ss = v0 * v0 + v1 * v1;
#pragma unroll
            for (int off = 1; off < 16; off <<= 1) ss += __shfl_xor(ss, off);
            if ((tid & 15) == 0) ((float*)(ws + WS_SSS))[srow * 32 + cb] = ss;
        } else if (which == 2) {
            const float* sp = (const float*)(ws + WS_SSS) + srow * 32 + col;
            float ss = sp[0] + sp[1];
#pragma unroll
            for (int off = 1; off < 16; off <<= 1) ss += __shfl_xor(ss, off);
            const float r2 = 1.0f / (ss * (1.0f / 1024.0f) + EPS);
            const float h0 = fmaxf(s0, 0.f), h1 = fmaxf(s1, 0.f);
            *(unsigned*)((bf16_t*)(ws + WS_H) + (size_t)grow * 4096 + gcol) = cvtpk(h0 * h0 * r2, h1 * h1 * r2);
            float t0, t1; skinny_get(red2, row, col, t0, t1);
            const float h2 = fmaxf(t0, 0.f), h3 = fmaxf(t1, 0.f);
            *(unsigned*)((bf16_t*)(ws + WS_H) + (size_t)grow * 4096 + gcol + 32) = cvtpk(h2 * h2 * r2, h3 * h3 * r2);
        } else {
            const float* xr = (const float*)(ws + WS_G) + (size_t)grow * 1024 + gcol;
            *(f32x2_t*)(a->out + O_YS + (size_t)srow * 1024 + gcol) = (f32x2_t){xr[0] + s0, xr[1] + s1};
        }
        __syncthreads();
    }
}

#define XB_TMO      128
#define XB_XCNT(j)  (256  + 64 * (j))
#define XB_XSUB(j)  (1280 + 64 * (j))
#define XB_XGEN(j)  (2304 + 64 * (j))
#define XB_TOP      3328
#define XB_TOPGEN   3392
#define XCD_BAR_WORDS 3456
#define XB_SPIN_CAP (1u << 18)

__device__ __forceinline__ unsigned xb_ld(unsigned* p)              { return __hip_atomic_load(p, __ATOMIC_RELAXED, __HIP_MEMORY_SCOPE_AGENT); }
__device__ __forceinline__ unsigned xb_add(unsigned* p, unsigned v) { return __hip_atomic_fetch_add(p, v, __ATOMIC_RELAXED, __HIP_MEMORY_SCOPE_AGENT); }
__device__ __forceinline__ unsigned xb_xcc_id() { return (unsigned)__builtin_amdgcn_s_getreg((3 << 11) | 20) & 0xFu; }
#define XB_SPIN(cond, bar) do { unsigned _sp = 0; while (cond) { __builtin_amdgcn_s_sleep(1); \
    if ((++_sp & 255u) == 0u) { if (xb_ld(&(bar)[XB_TMO])) break; if (_sp > XB_SPIN_CAP) { atomicAdd(&(bar)[XB_TMO], 1u); break; } } } } while (0)

struct XcdBarrier {
    unsigned* bar; unsigned x;
    volatile LAS unsigned* st;
};

__device__ __forceinline__ XcdBarrier xcd_barrier_post(unsigned* bar, volatile LAS unsigned* st) {
    XcdBarrier b; b.bar = bar; b.x = xb_xcc_id(); b.st = st;
    if (threadIdx.x == 0) (void)xb_add(&bar[XB_XCNT(b.x)], 1u);
    return b;
}
__device__ __forceinline__ void xcd_barrier_complete(unsigned* bar, unsigned x, unsigned& nloc, unsigned& nx) {
    const unsigned G = gridDim.x * gridDim.y * gridDim.z;
    unsigned sum, cnt, mine, sp = 0u;
    for (;;) {
        sum = 0u; cnt = 0u; mine = 0u;
#pragma unroll
        for (unsigned j = 0; j < 16; ++j) { const unsigned c = xb_ld(&bar[XB_XCNT(j)]); sum += c; cnt += (c > 0u) ? 1u : 0u; mine = (j == x) ? c : mine; }
        if (sum == G) break;
        __builtin_amdgcn_s_sleep(1);
        if ((++sp & 255u) == 0u) { if (xb_ld(&bar[XB_TMO])) break; if (sp > XB_SPIN_CAP) { atomicAdd(&bar[XB_TMO], 1u); break; } }
    }
    nloc = mine > 0u ? mine : 1u; nx = cnt > 0u ? cnt : 1u;
}

__device__ __forceinline__ void xcd_barrier(const XcdBarrier& b) {
    asm volatile("s_waitcnt vmcnt(0)" ::: "memory");
    __syncthreads();
    if (threadIdx.x == 0) {
        unsigned* bar = b.bar;
        __builtin_amdgcn_s_waitcnt(0);
        unsigned nloc = b.st[0], nx = b.st[1];
        if (nloc == 0u) { xcd_barrier_complete(bar, b.x, nloc, nx); b.st[0] = nloc; b.st[1] = nx; }
        const unsigned old = xb_add(&bar[XB_XSUB(b.x)], 1u);
        const unsigned gen = old / nloc;
        if (old + 1u == (gen + 1u) * nloc) {
            __builtin_amdgcn_fence(__ATOMIC_RELEASE, "agent");
            asm volatile("s_waitcnt vmcnt(0)" ::: "memory");
            const unsigned og = xb_add(&bar[XB_TOP], 1u);
            const unsigned tg = og / nx;
            if (og + 1u == (tg + 1u) * nx) xb_add(&bar[XB_TOPGEN], 1u);
            else XB_SPIN(xb_ld(&bar[XB_TOPGEN]) == tg, bar);
            __builtin_amdgcn_fence(__ATOMIC_ACQUIRE, "agent");
            xb_add(&bar[XB_XGEN(b.x)], 1u);
            asm volatile("s_waitcnt vmcnt(0)" ::: "memory");
        } else {
            XB_SPIN(xb_ld(&bar[XB_XGEN(b.x)]) == gen, bar);
            __builtin_amdgcn_fence(__ATOMIC_ACQUIRE, "agent");
            asm volatile("s_waitcnt vmcnt(0)" ::: "memory");
        }
    }
    __syncthreads();
}

__global__ void __launch_bounds__(512, 2) mega_fwd(Args a_) {
    extern __shared__ __attribute__((aligned(16))) unsigned char lds_raw[];
    LAS unsigned char* lds = (LAS unsigned char*)lds_raw;
    cg::grid_group grid = cg::this_grid();
    const int G = gridDim.x, bx = blockIdx.x;
    const int vcu = (G % 8 == 0) ? (bx % 8) * (G / 8) + bx / 8 : bx;
    KArgs a = (KArgs)__builtin_amdgcn_kernarg_segment_ptr();
#define RELOAD_ARGS() asm volatile("" : "+s"(a))
    unsigned char* ws;

    volatile LAS unsigned* bst = (volatile LAS unsigned*)(lds + LDS_BYTES - 64);
    if (threadIdx.x < 2) bst[threadIdx.x] = 0u;
    RELOAD_ARGS();
    __syncthreads();
    { int never = 0; asm volatile("" : "+s"(never)); if (never) grid.sync(); }
    RELOAD_ARGS();
    (void)xcd_barrier_post((unsigned*)(a->ws + WS_BAR), bst);
#define SEAM() do { RELOAD_ARGS(); XcdBarrier xb_; xb_.bar = (unsigned*)(a->ws + WS_BAR); xb_.x = xb_xcc_id(); xb_.st = bst; xcd_barrier(xb_); } while (0)
    RELOAD_ARGS();
    for (int rep_ = 0; rep_ < REP_P0; ++rep_) prologue(a, lds, vcu, G);
    SEAM();

    for (int rep_ = 0; rep_ < REP_SYNC; ++rep_) SEAM();
    RELOAD_ARGS(); ws = a->ws;
    for (int rep_ = 0; rep_ < REP_P1; ++rep_)
    {
        pg8::Gemm g{(const bf16_t*)(ws + WS_XN), (const bf16_t*)(ws + WS_WIN), M1, NIN, 1024}; pg8::StaticOrder S; S.init(M1, NIN, G, bx);
        EpiIn E{a->out, ws, a->in[I_QG], a->in[I_KG]};
        pg8::gemm_phase<EpiIn, pg8::StaticOrder, true, true>(lds, g, S, E);
    }
    { constexpr int NU = (M1 / 256) * (NIN / 256); const int full = NU / G, first_idle = NU - full * G;
      if (first_idle > 0 && first_idle < G) { if (bx >= first_idle) { RELOAD_ARGS(); convert_late_weights(a, lds, bx - first_idle, G - first_idle); } }
      else { RELOAD_ARGS(); convert_late_weights(a, lds, bx, G); } }
    SEAM();


    RELOAD_ARGS(); ws = a->ws;
    for (int rep_ = 0; rep_ < REP_P2A; ++rep_)
    for (int u = vcu; u < DB * 8 * 4; u += G) { int uu = u; asm volatile("" : "+s"(uu)); RELOAD_ARGS(); sample_unit(a, lds, uu >> 5, (uu >> 2) & 7, uu & 3); }
    SEAM();

    RELOAD_ARGS(); ws = a->ws;
    float lam;
    { const int lane = opaque_tid() & 63;
      const float s1 = wave_sum(a->in[I_LQ1][lane] * a->in[I_LK1][lane]), s2 = wave_sum(a->in[I_LQ2][lane] * a->in[I_LK2][lane]);
      lam = __builtin_bit_cast(float, __builtin_amdgcn_readfirstlane(__builtin_bit_cast(int, __expf(s1) - __expf(s2) + LAM_INIT))); }
    for (int u = vcu; u < DB * 8; u += G) sample_combine(a, lds, u >> 3, u & 7, lam);
    for (int rep_ = 0; rep_ < REP_P2B; ++rep_)
    for (int u = vcu; u < NBATCH * 8 * 8; u += G) {
        const int bh = u >> 3, s = u & 7, b = bh >> 3, h = bh & 7;
        for (int k = 0; k < 2 * REP_DIFF; ++k) { int qb = (k & 1) ? 15 - s : s, bb = b, hh = h; asm volatile("" : "+s"(qb), "+s"(bb), "+s"(hh)); RELOAD_ARGS(); diff_unit1(a, lds, bb, hh, qb, lam); }
        for (int k = 0; k < 2 * REP_SB; ++k) { int qb = (k & 1) ? 15 - s : s, bb = b, hh = h; asm volatile("" : "+s"(qb), "+s"(bb), "+s"(hh)); RELOAD_ARGS(); sb_unit(a, lds, bb, hh, qb); }
    }
    SEAM();

    for (int rep3_ = 0; rep3_ < REP_P3; ++rep3_) {
    RELOAD_ARGS(); ws = a->ws;
    {
        pg8::Gemm g{(const bf16_t*)(ws + WS_OD), (const bf16_t*)(ws + WS_WDO), RC, 1024, 1024}; pg8::StaticOrder S; S.init(RC, 1024, G, bx);
        EpiGateA E{(const bf16_t*)(ws + WS_G), (float*)(ws + WS_T1)};
        pg8::gemm_phase<EpiGateA, pg8::StaticOrder, true, true>(lds, g, S, E);
    }
    __syncthreads();
    RELOAD_ARGS(); ws = a->ws;
    {
        pg8::Gemm g{(const bf16_t*)(ws + WS_OS), (const bf16_t*)(ws + WS_WSO), RC, 1024, 512}; pg8::StaticOrder S; S.init(RC, 1024, G, bx);
        EpiGateB E{(const bf16_t*)(ws + WS_G), (const float*)(ws + WS_T1), (bf16_t*)(ws + WS_XN)};
        pg8::gemm_phase<EpiGateB, pg8::StaticOrder, true, true>(lds, g, S, E);
    }
    RELOAD_ARGS(); skinny_phase(a, lds, 0, vcu, G);
    __syncthreads();
    }
    SEAM();

    RELOAD_ARGS(); ws = a->ws;
    for (int rep_ = 0; rep_ < REP_P4; ++rep_)
    {
        pg8::Gemm g{(const bf16_t*)(ws + WS_XN), (const bf16_t*)(ws + WS_WOUT), RC, 1024, 1024}; pg8::StaticOrder S; S.init(RC, 1024, G, bx);
        EpiOut E{a->in[I_XP], a->in[I_XS], (float*)(ws + WS_G), (bf16_t*)(ws + WS_OD), (float*)(ws + WS_SS)};
        pg8::gemm_phase<EpiOut, pg8::StaticOrder, true, true>(lds, g, S, E);
    }
    RELOAD_ARGS(); skinny_phase(a, lds, 1, vcu, G);
    SEAM();

    RELOAD_ARGS(); ws = a->ws;
    for (int rep_ = 0; rep_ < REP_P5; ++rep_)
    {
        pg8::Gemm g{(const bf16_t*)(ws + WS_OD), (const bf16_t*)(ws + WS_W1), RC, DFF, 1024}; pg8::StaticOrder S; S.init(RC, DFF, G, bx);
        EpiFF1 E{(const float*)(ws + WS_SS), (bf16_t*)(ws + WS_H)};
        pg8::gemm_phase<EpiFF1, pg8::StaticOrder, true, true>(lds, g, S, E);
    }
    RELOAD_ARGS(); skinny_phase(a, lds, 2, vcu, G);
    SEAM();

    RELOAD_ARGS(); ws = a->ws;
    for (int rep_ = 0; rep_ < REP_P6; ++rep_)
    {
        pg8::Gemm g{(const bf16_t*)(ws + WS_H), (const bf16_t*)(ws + WS_W2), RC, 1024, DFF}; pg8::StaticOrder S; S.init(RC, 1024, G, bx);
        EpiFF2 E{(const float*)(ws + WS_G), a->out};
        pg8::gemm_phase<EpiFF2, pg8::StaticOrder, true, true>(lds, g, S, E);
    }
    RELOAD_ARGS(); skinny_phase(a, lds, 3, vcu, G);
}

extern "C" void kernel_launch(void* const* d_in, const int* in_sizes, int n_in, void* d_out, int out_size, void* d_ws, size_t ws_size, hipStream_t stream) {
    static int grid = 0;
    if (grid == 0) {
        if (n_in != 22 || ws_size < WS_END) { fprintf(stderr, "kernel_launch: unexpected n_in %d / ws %zu\n", n_in, ws_size); grid = -1; return; }
        int dev = 0, cus = 0, per_cu = 0;
        hipGetDevice(&dev);
        hipDeviceGetAttribute(&cus, hipDeviceAttributeMultiprocessorCount, dev);
        hipFuncSetAttribute((const void*)mega_fwd, hipFuncAttributeMaxDynamicSharedMemorySize, LDS_BYTES);
        hipOccupancyMaxActiveBlocksPerMultiprocessor(&per_cu, (const void*)mega_fwd, 512, LDS_BYTES);
        if (per_cu < 1) { fprintf(stderr, "kernel_launch: occupancy query says %d blocks/CU\n", per_cu); per_cu = 1; }
        (void)hipGetLastError();
        grid = cus * 1;
    }
    if (grid < 0) return;
    Args a{};
    for (int i = 0; i < 22; ++i) a.in[i] = (const float*)d_in[i];
    a.out = (float*)d_out; a.ws = (unsigned char*)d_ws;
    if (hipMemsetAsync((unsigned char*)d_ws + WS_BAR, 0, XCD_BAR_WORDS * 4, stream) != hipSuccess) { fprintf(stderr, "kernel_launch: hipMemsetAsync failed\n"); return; }
    void* args[] = {&a};
    hipError_t e = hipLaunchCooperativeKernel((const void*)mega_fwd, dim3(grid), dim3(512), args, LDS_BYTES, stream);
    if (e != hipSuccess) fprintf(stderr, "cooperative launch failed: %s (grid %d)\n", hipGetErrorString(e), grid);
}
```

```cpp
#include <hip/hip_runtime.h>
#include <hip/hip_cooperative_groups.h>
#include <cstdio>
#include <cstdint>
namespace cg = cooperative_groups;
__device__ __forceinline__ int opaque_tid() { int t = threadIdx.x; asm volatile("" : "+v"(t)); return t; }
namespace pg8 {
#define PG8_LAS __attribute__((address_space(3)))
typedef unsigned short bf16_t;
typedef short bf16x8 __attribute__((ext_vector_type(8)));
typedef float f32x4 __attribute__((ext_vector_type(4)));
typedef unsigned u32x4 __attribute__((ext_vector_type(4)));
constexpr int BM = 256, BK = 64, HALF = 128, HTB = HALF * BK * 2  , STAGE_BYTES = 8 * HTB, NXCD = 8, WGM = 8;

__host__ __device__ __forceinline__ int lds_byte(int r, int c) { const int st = (r >> 4) * 2 + (c >> 5), rr = r & 15, cc = c & 31, ob = rr * 64 + cc * 2; return st * 1024 + (ob ^ (((ob >> 9) & 1) << 5)); }
__host__ __device__ __forceinline__ void stage_rc(int b, int& R, int& C) { const int st = b / 1024, sb = b % 1024, swz = sb ^ (((sb >> 9) & 1) << 5); R = (st >> 1) * 16 + swz / 64; C = (st & 1) * 32 + (swz % 64) / 2; }
__host__ __device__ __forceinline__ int perm32(int rho) { const int n = rho >> 4, i = rho & 15; return 8 * (i >> 2) + 4 * n + (i & 3); }

struct Unit { int pm, pn; };
struct Gemm { const bf16_t* A; const bf16_t* Bt; int M, N, K; };

struct StaticOrder {
    int nM, nN, nwg, G, c;
    __host__ __device__ void init(int M, int N, int G_, int c_) { nM = M / BM; nN = N / BM; nwg = nM * nN; G = G_; c = c_; }
    __host__ __device__ bool next(int i, Unit& u) const {
        const long L = (long)i * G + c; if (L >= nwg) return false;
        int wgid = (int)L; { const int q = nwg / NXCD, r = nwg % NXCD, xcd = wgid % NXCD, off = wgid / NXCD; wgid = (xcd < r ? xcd * (q + 1) : r * (q + 1) + (xcd - r) * q) + off; }
        const int nig = WGM * nN, gid = wgid / nig, fm = gid * WGM, gsz = (nM - fm) < WGM ? (nM - fm) : WGM;
        u.pm = fm + ((wgid % nig) % gsz); u.pn = (wgid % nig) / gsz; return true;
    }
    __device__ __forceinline__ void a_ready(const Unit&) const {}
    __device__ __forceinline__ void done(const Unit&) const {}
};

__device__ __forceinline__ unsigned cvt_pk_bf16(float lo, float hi) { unsigned r; asm volatile("v_cvt_pk_bf16_f32 %0, %1, %2" : "=v"(r) : "v"(lo), "v"(hi)); return r; }
typedef float f32x2 __attribute__((ext_vector_type(2)));
template <class Epi, class Sched, bool ALIGN_EPI = false, bool SP2 = false>
__device__ __forceinline__ void gemm_phase(PG8_LAS unsigned char* lds, const Gemm g, const Sched& S, const Epi& E) {
    const int tid = opaque_tid(), wid = __builtin_amdgcn_readfirstlane(tid >> 6), lane = tid & 63, wr = wid >> 2, wc = wid & 3, fr = lane & 15, fq = lane >> 4;
    const int K = g.K, nt = K / BK;
    unsigned voffA[2], voffB[2];
#pragma unroll
    for (int i = 0; i < 2; ++i) { int R, C; stage_rc(tid * 16 + i * 8192, R, C); const int Rb = Epi::PERM ? ((R & ~31) + perm32(R & 31)) : R;
        voffA[i] = (unsigned)(R * K + C) * 2u; voffB[i] = (unsigned)(Rb * K + C) * 2u; }
    const size_t kstep = (size_t)(BK * 2);
    const size_t hstep = (size_t)HALF * K * 2;
    const size_t tstep = 2 * hstep;
    const unsigned ldsw = (unsigned)wid * 1024u;
    const int aoff = lds_byte(wr * 64 + fr, fq * 8), boff = lds_byte(wc * 32 + fr, fq * 8);
#define PG8_SA(b, h) (((b) * 2 + (h)) * HTB)
#define PG8_SB(b, h) ((4 + (b) * 2 + (h)) * HTB)
#define PG8_STAGE(bufoff, gbase, voff) do { _Pragma("unroll") for (int _i = 0; _i < 2; ++_i) \
        __builtin_amdgcn_global_load_lds((const unsigned*)((const char*)(gbase) + (voff)[_i]), (PG8_LAS unsigned*)(lds + (bufoff) + ldsw + _i * 8192), 16, 0, 0); } while (0)
#define PG8_LDA(dst, b, h) do { _Pragma("unroll") for (int m = 0; m < 4; ++m) _Pragma("unroll") for (int k = 0; k < 2; ++k) dst[m][k] = *(const PG8_LAS bf16x8*)(lds + PG8_SA(b, h) + aoff + m * 2048 + k * 1024); } while (0)
#define PG8_LDB(dst, b, h) do { _Pragma("unroll") for (int n = 0; n < 2; ++n) _Pragma("unroll") for (int k = 0; k < 2; ++k) dst[n][k] = *(const PG8_LAS bf16x8*)(lds + PG8_SB(b, h) + boff + n * 2048 + k * 1024); } while (0)
#define PG8_MMA(ai, bj, At, Bt) do { __builtin_amdgcn_s_setprio(1); _Pragma("unroll") for (int m = 0; m < 4; ++m) _Pragma("unroll") for (int n = 0; n < 2; ++n) _Pragma("unroll") for (int k = 0; k < 2; ++k) \
        acc[ai][bj][m][n] = __builtin_amdgcn_mfma_f32_16x16x32_bf16(Bt[n][k], At[m][k], acc[ai][bj][m][n], 0, 0, 0); __builtin_amdgcn_s_setprio(0); } while (0)
#define PG8_WAIT_V(n) asm volatile("s_waitcnt vmcnt(" #n ")" ::: "memory")
#define PG8_WAIT_L(n) asm volatile("s_waitcnt lgkmcnt(" #n ")" ::: "memory")
#define PG8_BAR __builtin_amdgcn_s_barrier()
#define PG8_SCHED __builtin_amdgcn_sched_barrier(0)
    Unit cur, nxt; int ui = 0;
    if (!S.next(0, cur)) return;
    f32x4 acc[2][2][4][2];
#pragma unroll
    for (int a = 0; a < 2; ++a)
#pragma unroll
        for (int b = 0; b < 2; ++b)
#pragma unroll
            for (int m = 0; m < 4; ++m)
#pragma unroll
                for (int n = 0; n < 2; ++n) acc[a][b][m][n] = (f32x4){0.f, 0.f, 0.f, 0.f};
    bf16x8 At[4][2], B0[2][2], B1[2][2];
    const char* cA = (const char*)g.A + (size_t)cur.pm * tstep; const char* cB = (const char*)g.Bt + (size_t)cur.pn * tstep;
    S.a_ready(cur);
    if constexpr (SP2) {
        PG8_STAGE(PG8_SB(0, 0), cB, voffB); PG8_STAGE(PG8_SB(0, 1), cB + hstep, voffB); PG8_STAGE(PG8_SA(0, 0), cA, voffA); PG8_STAGE(PG8_SA(0, 1), cA + hstep, voffA);
        if (wr == 1) PG8_BAR;
        PG8_WAIT_V(2); PG8_BAR;
        PG8_STAGE(PG8_SB(1, 0), cB + kstep, voffB); PG8_STAGE(PG8_SA(1, 0), cA + kstep, voffA); PG8_STAGE(PG8_SB(1, 1), cB + hstep + kstep, voffB);
        PG8_WAIT_V(6); PG8_BAR;
    } else {
        PG8_STAGE(PG8_SB(0, 0), cB, voffB); PG8_STAGE(PG8_SA(0, 0), cA, voffA); PG8_STAGE(PG8_SB(0, 1), cB + hstep, voffB); PG8_STAGE(PG8_SA(0, 1), cA + hstep, voffA);
        if (wr == 1) PG8_BAR;
        PG8_WAIT_V(4); PG8_BAR;
        PG8_STAGE(PG8_SB(1, 0), cB + kstep, voffB); PG8_STAGE(PG8_SA(1, 0), cA + kstep, voffA); PG8_STAGE(PG8_SB(1, 1), cB + hstep + kstep, voffB);
        PG8_WAIT_V(6); PG8_BAR;
    }
    for (;;) {
        const bool has_next = S.next(ui + 1, nxt);
        const char* nA = has_next ? (const char*)g.A + (size_t)nxt.pm * tstep : cA; const char* nB = has_next ? (const char*)g.Bt + (size_t)nxt.pn * tstep : cB;
        for (int t = 0; t < nt; t += 2) {
            const bool last = (t == nt - 2);
            const char* a1 = cA + (size_t)(t + 1) * kstep;
            const char* a2 = last ? nA : cA + (size_t)(t + 2) * kstep; const char* b2 = last ? nB : cB + (size_t)(t + 2) * kstep;
            const char* a3 = a2 + kstep; const char* b3 = b2 + kstep;
            if (last && has_next) S.a_ready(nxt);
            if constexpr (SP2) {
            PG8_LDB(B0, 0, 0); PG8_LDB(B1, 0, 1); PG8_SCHED; PG8_LDA(At, 0, 0); PG8_STAGE(PG8_SA(1, 1), a1 + hstep, voffA);
            PG8_WAIT_V(8); PG8_WAIT_L(0); PG8_BAR; PG8_MMA(0, 0, At, B0); PG8_MMA(0, 1, At, B1); PG8_BAR; PG8_SCHED;
            PG8_LDA(At, 0, 1); PG8_STAGE(PG8_SB(0, 0), b2, voffB); PG8_STAGE(PG8_SB(0, 1), b2 + hstep, voffB); PG8_STAGE(PG8_SA(0, 0), a2, voffA);
            PG8_WAIT_V(8); PG8_WAIT_L(0); PG8_BAR; PG8_MMA(1, 0, At, B0); PG8_MMA(1, 1, At, B1); PG8_BAR; PG8_SCHED;
            PG8_LDB(B0, 1, 0); PG8_LDB(B1, 1, 1); PG8_SCHED; PG8_LDA(At, 1, 0); PG8_STAGE(PG8_SA(0, 1), a2 + hstep, voffA);
            PG8_WAIT_V(8); PG8_WAIT_L(0); PG8_BAR; PG8_MMA(0, 0, At, B0); PG8_MMA(0, 1, At, B1); PG8_BAR; PG8_SCHED;
            PG8_LDA(At, 1, 1); PG8_STAGE(PG8_SB(1, 0), b3, voffB); PG8_STAGE(PG8_SB(1, 1), b3 + hstep, voffB); PG8_STAGE(PG8_SA(1, 0), a3, voffA);
            PG8_WAIT_V(8); PG8_WAIT_L(0); PG8_BAR; PG8_MMA(1, 0, At, B0); PG8_MMA(1, 1, At, B1); PG8_BAR; PG8_SCHED;
            } else {
            PG8_LDB(B0, 0, 0); PG8_SCHED; PG8_LDA(At, 0, 0); PG8_STAGE(PG8_SA(1, 1), a1 + hstep, voffA);
            PG8_WAIT_L(8); PG8_BAR; PG8_WAIT_L(0); PG8_MMA(0, 0, At, B0); PG8_BAR; PG8_SCHED;
            PG8_LDB(B1, 0, 1); PG8_STAGE(PG8_SB(0, 0), b2, voffB);
            PG8_BAR; PG8_WAIT_L(0); PG8_MMA(0, 1, At, B1); PG8_BAR;
            PG8_LDA(At, 0, 1); PG8_STAGE(PG8_SA(0, 0), a2, voffA);
            PG8_BAR; PG8_WAIT_L(0); PG8_MMA(1, 0, At, B0); PG8_BAR; PG8_SCHED;
            PG8_STAGE(PG8_SB(0, 1), b2 + hstep, voffB);
            PG8_WAIT_V(6); PG8_BAR; PG8_MMA(1, 1, At, B1); PG8_BAR;
            PG8_LDB(B0, 1, 0); PG8_SCHED; PG8_LDA(At, 1, 0); PG8_STAGE(PG8_SA(0, 1), a2 + hstep, voffA);
            PG8_WAIT_L(8); PG8_BAR; PG8_WAIT_L(0); PG8_MMA(0, 0, At, B0); PG8_BAR; PG8_SCHED;
            PG8_LDB(B1, 1, 1); PG8_STAGE(PG8_SB(1, 0), b3, voffB);
            PG8_BAR; PG8_WAIT_L(0); PG8_MMA(0, 1, At, B1); PG8_BAR;
            PG8_LDA(At, 1, 1); PG8_STAGE(PG8_SA(1, 0), a3, voffA);
            PG8_BAR; PG8_WAIT_L(0); PG8_MMA(1, 0, At, B0); PG8_BAR; PG8_SCHED;
            PG8_STAGE(PG8_SB(1, 1), b3 + hstep, voffB);
            PG8_WAIT_V(6); PG8_BAR; PG8_MMA(1, 1, At, B1); PG8_BAR;
            }
        }
        if constexpr (ALIGN_EPI) { if (wr == 0) PG8_BAR; }
        if constexpr (!Epi::AFTER_DRAIN) { E(acc, cur, wr, wc, fr, fq); S.done(cur); }
        if (!has_next) break;
#pragma unroll
        for (int a = 0; a < 2; ++a)
#pragma unroll
            for (int b = 0; b < 2; ++b)
#pragma unroll
                for (int m = 0; m < 4; ++m)
#pragma unroll
                    for (int n = 0; n < 2; ++n) acc[a][b][m][n] = (f32x4){0.f, 0.f, 0.f, 0.f};
        cur = nxt; cA = nA; cB = nB; ++ui;
        if constexpr (ALIGN_EPI) { if (wr == 1) PG8_BAR; }
    }
    PG8_WAIT_V(0);
    if constexpr (!ALIGN_EPI) { if (wr == 0) PG8_BAR; }
    PG8_BAR;
    if constexpr (Epi::AFTER_DRAIN) { E.fused(acc, cur, wr, wc, fr, fq, lds, wid, lane); S.done(cur); }
#undef PG8_SA
#undef PG8_SB
#undef PG8_STAGE
#undef PG8_LDA
#undef PG8_LDB
#undef PG8_MMA
#undef PG8_WAIT_V
#undef PG8_WAIT_L
#undef PG8_BAR
#undef PG8_SCHED
}
}

#define LAS __attribute__((address_space(3)))
typedef unsigned short bf16_t;
typedef short bf16x8 __attribute__((ext_vector_type(8)));
typedef float f32x4 __attribute__((ext_vector_type(4)));
typedef float f32x16 __attribute__((ext_vector_type(16)));
typedef unsigned u32x4 __attribute__((ext_vector_type(4)));
typedef unsigned u32x2 __attribute__((ext_vector_type(2)));
typedef float f32x2_t __attribute__((ext_vector_type(2)));
typedef __bf16 bf16x2_t __attribute__((ext_vector_type(2)));

constexpr int DM = 1024, NBATCH = 4, SEQ = 4096, NMETA = 16, TP = SEQ + NMETA;
constexpr int DB = 8, DS = 32, PAST = 4096;
constexpr int RP = NBATCH * TP;
constexpr int RS = DB * DS;
constexpr int R1 = RP + RS;
constexpr int M1 = 16896;
constexpr int RC = NBATCH * SEQ;
constexpr int M2 = RC + RS;
constexpr int NIN = 6656, DFF = 4096;
constexpr float EPS = 1e-6f;
constexpr float QSCALE = 0.18033688011112042f;
constexpr float LAM_INIT = 0.2f;

constexpr size_t O_Y = 0, O_YS = 16777216, O_PDK = 17039360, O_PDV = 33882112, O_PSK = 50724864, O_PSV = 59146240,
                 O_SDK = 67567616, O_SDV = 67829760, O_SSK = 68091904, O_SSV = 68222976;

constexpr size_t MiB = 1u << 20;
constexpr size_t WS_WIN = 0, WS_WDO = 14 * MiB, WS_WSO = 16 * MiB, WS_WOUT = 17 * MiB, WS_W1 = 19 * MiB, WS_W2 = 27 * MiB;
constexpr size_t WS_ROPE = 35 * MiB, WS_SS = 36 * MiB, WS_BAR = 36 * MiB + 1536 * 1024, WS_PART = 38 * MiB;
constexpr size_t WS_XN = 50 * MiB;
constexpr size_t WS_QD = 83 * MiB, WS_KD = 116 * MiB, WS_VD = 149 * MiB;
constexpr size_t WS_QS = 182 * MiB, WS_KS = 199 * MiB, WS_VS = 216 * MiB;
constexpr size_t WS_T1 = 83 * MiB;
constexpr size_t WS_H = 83 * MiB;
constexpr size_t WS_G = 233 * MiB;
constexpr size_t WS_OD = 298 * MiB;
constexpr size_t WS_OS = 331 * MiB;
constexpr size_t WS_END = 348 * MiB;
constexpr int PART_FLOATS = 10400;

constexpr int LDS_BYTES = 147456;
#ifndef REP_P0
#define REP_P0 1
#endif
#ifndef REP_P1
#define REP_P1 1
#endif
#ifndef REP_P4
#define REP_P4 1
#endif
#ifndef REP_P5
#define REP_P5 1
#endif
#ifndef REP_P6
#define REP_P6 1
#endif
#ifndef REP_SYNC
#define REP_SYNC 0
#endif
#ifndef REP_DIFF
#define REP_DIFF 1
#endif
#ifndef REP_SB
#define REP_SB 1
#endif
#ifndef REP_P3
#define REP_P3 1
#endif
#ifndef REP_P2A
#define REP_P2A 1
#endif
#ifndef REP_P2B
#define REP_P2B 1
#endif

__device__ __forceinline__ unsigned cvtpk(float lo, float hi) { f32x2_t v = {lo, hi}; bf16x2_t b = __builtin_convertvector(v, bf16x2_t); return __builtin_bit_cast(unsigned, b); }
__device__ __forceinline__ float bf_lo(unsigned u) { return __uint_as_float(u << 16); }
__device__ __forceinline__ float bf_hi(unsigned u) { return __uint_as_float(u & 0xffff0000u); }
__device__ __forceinline__ int crow(int r, int hi) { return (r & 3) + 8 * (r >> 2) + 4 * hi; }
__device__ __forceinline__ float ex2(float x) { return __builtin_amdgcn_exp2f(x); }
__device__ __forceinline__ float lg2(float x) { return __builtin_amdgcn_logf(x); }
__device__ __forceinline__ float wave_sum(float v) {
#pragma unroll
    for (int o = 1; o < 64; o <<= 1) v += __shfl_xor(v, o);
    return v;
}
__device__ __forceinline__ u32x4 pack8(const float* v) { u32x4 w; w.x = cvtpk(v[0], v[1]); w.y = cvtpk(v[2], v[3]); w.z = cvtpk(v[4], v[5]); w.w = cvtpk(v[6], v[7]); return w; }

struct Args { const float* in[22]; float* out; unsigned char* ws; };
typedef const __attribute__((address_space(4))) Args* KArgs;
enum { I_XP = 0, I_XS, I_CDK, I_CDV, I_CSK, I_CSV, I_META, I_GMIX, I_WIN, I_QG, I_KG, I_LQ1, I_LK1, I_LQ2, I_LK2, I_SUBG, I_WDO, I_WSO, I_WOUT, I_GFFN, I_W1, I_W2 };

struct EpiIn {
    static constexpr bool PERM = true, AFTER_DRAIN = false;
    float* out; unsigned char* ws; const float* qg; const float* kg;
    __device__ __forceinline__ void operator()(const f32x4 (&acc)[2][2][4][2], const pg8::Unit& u, int wr, int wc, int fr, int fq) const {
        const int pn = u.pn;
        int type, cb;
        if (pn < 4) { type = 0; cb = 0; } else if (pn < 8) { type = 1; cb = 1024; } else if (pn < 12) { type = 2; cb = 2048; }
        else if (pn < 14) { type = 3; cb = 3072; } else if (pn < 16) { type = 4; cb = 3584; } else if (pn < 18) { type = 5; cb = 4096; } else { type = 6; cb = 4608; }
        const int col0 = pn * 256 + wc * 64 + fq * 8 - cb;
        const float* rope = (const float*)(ws + WS_ROPE);
        float gv[2][8];
        if (type <= 1) { const float* g = (type == 0) ? qg : kg;
#pragma unroll
            for (int bj = 0; bj < 2; ++bj)
#pragma unroll
                for (int i = 0; i < 8; ++i) gv[bj][i] = g[32 * bj + 8 * fq + i]; }
        bf16_t* bdst; int bld; size_t op, os; int ow;
        switch (type) {
            case 0: bdst = (bf16_t*)(ws + WS_QD); bld = 1024; op = 0; os = 0; ow = 0; break;
            case 1: bdst = (bf16_t*)(ws + WS_KD); bld = 1024; op = O_PDK; os = O_SDK; ow = 1024; break;
            case 2: bdst = (bf16_t*)(ws + WS_VD); bld = 1024; op = O_PDV; os = O_SDV; ow = 1024; break;
            case 3: bdst = (bf16_t*)(ws + WS_QS); bld = 512; op = 0; os = 0; ow = 0; break;
            case 4: bdst = (bf16_t*)(ws + WS_KS); bld = 512; op = O_PSK; os = O_SSK; ow = 512; break;
            case 5: bdst = (bf16_t*)(ws + WS_VS); bld = 512; op = O_PSV; os = O_SSV; ow = 512; break;
            default: bdst = (bf16_t*)(ws + WS_G); bld = 2048; op = 0; os = 0; ow = 0; break;
        }
#pragma unroll
        for (int ai = 0; ai < 2; ++ai)
#pragma unroll
            for (int m = 0; m < 4; ++m) {
                const int row = u.pm * 256 + ai * 128 + wr * 64 + m * 16 + fr;
                const bool valid = row < R1;
                const bool samp = row >= RP;
                int pos, crw;
                if (!samp) { const int b = row / TP; const int t = row - b * TP; pos = t; crw = (t >= NMETA) ? b * SEQ + t - NMETA : -1; }
                else { const int r = row - RP; pos = valid ? PAST + (r & 31) : 0; crw = RC + r; }
                float v[2][8];
#pragma unroll
                for (int bj = 0; bj < 2; ++bj)
#pragma unroll
                    for (int n = 0; n < 2; ++n)
#pragma unroll
                        for (int e = 0; e < 4; ++e) v[bj][4 * n + e] = acc[ai][bj][m][n][e];
                if (type <= 1) {
                    float ss = 0.f;
#pragma unroll
                    for (int bj = 0; bj < 2; ++bj)
#pragma unroll
                        for (int i = 0; i < 8; ++i) ss += v[bj][i] * v[bj][i];
                    ss += __shfl_xor(ss, 16); ss += __shfl_xor(ss, 32);
                    const float rstd = rsqrtf(ss * (1.0f / 64.0f) + EPS);
#pragma unroll
                    for (int bj = 0; bj < 2; ++bj)
#pragma unroll
                        for (int i = 0; i < 8; ++i) v[bj][i] *= rstd * gv[bj][i];
                    float pv[8];
#pragma unroll
                    for (int i = 0; i < 8; ++i) pv[i] = __shfl_xor(v[0][i], 16);
                    if (fq < 2) { const float* rp = rope + pos * 16;
#pragma unroll
                        for (int i = 0; i < 8; ++i) { const float c = rp[i], s = rp[8 + i]; v[0][i] = (fq == 0) ? (v[0][i] * c - pv[i] * s) : (v[0][i] * c + pv[i] * s); } }
                }
                if (type == 0 || type == 3) {
#pragma unroll
                    for (int bj = 0; bj < 2; ++bj)
#pragma unroll
                        for (int i = 0; i < 8; ++i) v[bj][i] *= QSCALE;
                }
                if (type == 6) {
#pragma unroll
                    for (int bj = 0; bj < 2; ++bj)
#pragma unroll
                        for (int i = 0; i < 8; ++i) v[bj][i] = __builtin_amdgcn_rcpf(1.0f + __expf(-v[bj][i]));
                }
                const int brow = (type == 6) ? crw : row;
                if (valid && brow >= 0) {
#pragma unroll
                    for (int bj = 0; bj < 2; ++bj) {
                        const int c = col0 + 32 * bj;
                        *(u32x4*)(bdst + (size_t)brow * bld + c) = pack8(v[bj]);
                        if (ow) { float* o = samp ? out + os + (size_t)(row - RP) * ow + c : out + op + (size_t)row * ow + c;
                            __builtin_nontemporal_store((f32x4){v[bj][0], v[bj][1], v[bj][2], v[bj][3]}, (f32x4*)o); __builtin_nontemporal_store((f32x4){v[bj][4], v[bj][5], v[bj][6], v[bj][7]}, (f32x4*)(o + 4)); }
                    }
                }
            }
    }
};

struct EpiGateA {
    static constexpr bool PERM = true, AFTER_DRAIN = false;
    const bf16_t* G; float* T1;
    __device__ __forceinline__ void operator()(const f32x4 (&acc)[2][2][4][2], const pg8::Unit& u, int wr, int wc, int fr, int fq) const {
        const int row0 = u.pm * 256 + wr * 64 + fr, c0 = u.pn * 256 + wc * 64 + fq * 8;
        u32x4 g[2][4][2];
#pragma unroll
        for (int ai = 0; ai < 2; ++ai)
#pragma unroll
            for (int m = 0; m < 4; ++m)
#pragma unroll
                for (int bj = 0; bj < 2; ++bj) g[ai][m][bj] = *(const u32x4*)(G + (size_t)(row0 + ai * 128 + m * 16) * 2048 + c0 + bj * 32);
#pragma unroll
        for (int ai = 0; ai < 2; ++ai)
#pragma unroll
            for (int m = 0; m < 4; ++m)
#pragma unroll
                for (int bj = 0; bj < 2; ++bj) { const u32x4 gg = g[ai][m][bj];
                    const f32x4 a0 = acc[ai][bj][m][0], a1 = acc[ai][bj][m][1];
                    bf16_t* t = (bf16_t*)T1 + (size_t)(row0 + ai * 128 + m * 16) * 1024 + c0 + bj * 32;
                    float v[8] = {bf_lo(gg.x) * a0[0], bf_hi(gg.x) * a0[1], bf_lo(gg.y) * a0[2], bf_hi(gg.y) * a0[3], bf_lo(gg.z) * a1[0], bf_hi(gg.z) * a1[1], bf_lo(gg.w) * a1[2], bf_hi(gg.w) * a1[3]};
                    *(u32x4*)t = pack8(v); }
    }
};
struct EpiGateB {
    static constexpr bool PERM = true, AFTER_DRAIN = false;
    const bf16_t* G; const float* T1; bf16_t* MG;
    __device__ __forceinline__ void operator()(const f32x4 (&acc)[2][2][4][2], const pg8::Unit& u, int wr, int wc, int fr, int fq) const {
        const int row0 = u.pm * 256 + wr * 64 + fr, c0 = u.pn * 256 + wc * 64 + fq * 8;
#pragma unroll
        for (int ai = 0; ai < 2; ++ai)
#pragma unroll
            for (int mh = 0; mh < 2; ++mh) {
                u32x4 g[2][2], tb[2][2];
#pragma unroll
                for (int mm = 0; mm < 2; ++mm)
#pragma unroll
                    for (int bj = 0; bj < 2; ++bj) { const size_t r = (size_t)(row0 + ai * 128 + (2 * mh + mm) * 16); const int c = c0 + bj * 32;
                        g[mm][bj] = *(const u32x4*)(G + r * 2048 + 1024 + c); tb[mm][bj] = *(const u32x4*)((const bf16_t*)T1 + r * 1024 + c); }
#pragma unroll
                for (int mm = 0; mm < 2; ++mm)
#pragma unroll
                    for (int bj = 0; bj < 2; ++bj) { const int m = 2 * mh + mm; const size_t r = (size_t)(row0 + ai * 128 + m * 16); const int c = c0 + bj * 32;
                        const u32x4 gg = g[mm][bj]; const f32x4 a0 = acc[ai][bj][m][0], a1 = acc[ai][bj][m][1]; const u32x4 tt = tb[mm][bj];
                        const f32x4 x0 = {bf_lo(tt.x), bf_hi(tt.x), bf_lo(tt.y), bf_hi(tt.y)}, x1 = {bf_lo(tt.z), bf_hi(tt.z), bf_lo(tt.w), bf_hi(tt.w)};
                        float v[8] = {x0[0] + bf_lo(gg.x) * a0[0], x0[1] + bf_hi(gg.x) * a0[1], x0[2] + bf_lo(gg.y) * a0[2], x0[3] + bf_hi(gg.y) * a0[3],
                                      x1[0] + bf_lo(gg.z) * a1[0], x1[1] + bf_hi(gg.z) * a1[1], x1[2] + bf_lo(gg.w) * a1[2], x1[3] + bf_hi(gg.w) * a1[3]};
                        *(u32x4*)(MG + r * 1024 + c) = pack8(v); }
            }
    }
};
struct EpiOut {
    static constexpr bool PERM = true, AFTER_DRAIN = false;
    const float* xp; const float* xs; float* X1; bf16_t* X1b; float* SS;
    __device__ __forceinline__ void operator()(const f32x4 (&acc)[2][2][4][2], const pg8::Unit& u, int wr, int wc, int fr, int fq) const {
        const int row0 = u.pm * 256 + wr * 64 + fr, c0 = u.pn * 256 + wc * 64 + fq * 8;
#pragma unroll
        for (int ai = 0; ai < 2; ++ai) {
            f32x4 xv[4][2][2];
#pragma unroll
            for (int m = 0; m < 4; ++m) { const int row = row0 + ai * 128 + m * 16;
                const float* xr = (row < RC) ? xp + (size_t)row * 1024 : xs + (size_t)(row - RC) * 1024;
#pragma unroll
                for (int bj = 0; bj < 2; ++bj) { xv[m][bj][0] = __builtin_nontemporal_load((const f32x4*)(xr + c0 + bj * 32)); xv[m][bj][1] = __builtin_nontemporal_load((const f32x4*)(xr + c0 + bj * 32 + 4)); } }
#pragma unroll
            for (int m = 0; m < 4; ++m) { const int row = row0 + ai * 128 + m * 16;
                float ss = 0.f;
#pragma unroll
                for (int bj = 0; bj < 2; ++bj) { const int c = c0 + bj * 32;
                    const f32x4 a0 = acc[ai][bj][m][0] + xv[m][bj][0], a1 = acc[ai][bj][m][1] + xv[m][bj][1];
                    *(f32x4*)(X1 + (size_t)row * 1024 + c) = a0; *(f32x4*)(X1 + (size_t)row * 1024 + c + 4) = a1;
                    float v[8] = {a0[0], a0[1], a0[2], a0[3], a1[0], a1[1], a1[2], a1[3]};
                    *(u32x4*)(X1b + (size_t)row * 1024 + c) = pack8(v);
#pragma unroll
                    for (int i = 0; i < 8; ++i) ss += v[i] * v[i]; }
                ss += __shfl_xor(ss, 16); ss += __shfl_xor(ss, 32);
                if (fq == 0) SS[(size_t)row * 16 + u.pn * 4 + wc] = ss; }
        }
    }
};
struct EpiFF1 {
    static constexpr bool PERM = true, AFTER_DRAIN = false;
    const float* SS; bf16_t* H;
    __device__ __forceinline__ void operator()(const f32x4 (&acc)[2][2][4][2], const pg8::Unit& u, int wr, int wc, int fr, int fq) const {
        const int row0 = u.pm * 256 + wr * 64 + fr, c0 = u.pn * 256 + wc * 64 + fq * 8;
#pragma unroll
        for (int ai = 0; ai < 2; ++ai) {
            f32x4 sv[4][4];
#pragma unroll
            for (int m = 0; m < 4; ++m) { const f32x4* sp = (const f32x4*)(SS + (size_t)(row0 + ai * 128 + m * 16) * 16);
#pragma unroll
                for (int i = 0; i < 4; ++i) sv[m][i] = sp[i]; }
#pragma unroll
            for (int m = 0; m < 4; ++m) { const int row = row0 + ai * 128 + m * 16;
                const f32x4 s0 = sv[m][0], s1 = sv[m][1], s2 = sv[m][2], s3 = sv[m][3];
                const float s = ((s0[0] + s0[1]) + (s0[2] + s0[3])) + ((s1[0] + s1[1]) + (s1[2] + s1[3])) + ((s2[0] + s2[1]) + (s2[2] + s2[3])) + ((s3[0] + s3[1]) + (s3[2] + s3[3]));
                const float r2 = 1.0f / (s * (1.0f / 1024.0f) + EPS);
#pragma unroll
                for (int bj = 0; bj < 2; ++bj) { float v[8];
#pragma unroll
                    for (int n = 0; n < 2; ++n)
#pragma unroll
                        for (int e = 0; e < 4; ++e) { const float a = fmaxf(acc[ai][bj][m][n][e], 0.f); v[4 * n + e] = a * a * r2; }
                    *(u32x4*)(H + (size_t)row * 4096 + c0 + bj * 32) = pack8(v); } }
        }
    }
};
struct EpiFF2 {
    static constexpr bool PERM = true, AFTER_DRAIN = false;
    const float* X1; float* out;
    __device__ __forceinline__ void operator()(const f32x4 (&acc)[2][2][4][2], const pg8::Unit& u, int wr, int wc, int fr, int fq) const {
        const int row0 = u.pm * 256 + wr * 64 + fr, c0 = u.pn * 256 + wc * 64 + fq * 8;
#pragma unroll
        for (int ai = 0; ai < 2; ++ai) {
            f32x4 xv[4][2][2];
#pragma unroll
            for (int m = 0; m < 4; ++m) { const float* xr = X1 + (size_t)(row0 + ai * 128 + m * 16) * 1024 + c0;
#pragma unroll
                for (int bj = 0; bj < 2; ++bj) { xv[m][bj][0] = *(const f32x4*)(xr + bj * 32); xv[m][bj][1] = *(const f32x4*)(xr + bj * 32 + 4); } }
#pragma unroll
            for (int m = 0; m < 4; ++m) { const int row = row0 + ai * 128 + m * 16;
                float* dst = (row < RC) ? out + O_Y + (size_t)row * 1024 : out + O_YS + (size_t)(row - RC) * 1024;
#pragma unroll
                for (int bj = 0; bj < 2; ++bj) { const int c = c0 + bj * 32;
                    __builtin_nontemporal_store(acc[ai][bj][m][0] + xv[m][bj][0], (f32x4*)(dst + c)); __builtin_nontemporal_store(acc[ai][bj][m][1] + xv[m][bj][1], (f32x4*)(dst + c + 4)); } }
        }
    }
};

__device__ __forceinline__ void p0_transpose_item(const float* W, int K, int N, bf16_t* WT, const float* gk, LAS float* scr, int item, int lane, int kmask = 0x7fffffff, float gscale = 1.0f) {
    const int nblk = N / 32, kb = item / nblk, nb = item % nblk, k0 = 64 * kb, n0 = 32 * nb;
    { f32x4 v[8];
#pragma unroll
      for (int i = 0; i < 8; ++i) v[i] = __builtin_nontemporal_load((const f32x4*)(W + (size_t)(k0 + 8 * i + (lane >> 3)) * N + n0 + 4 * (lane & 7)));
#pragma unroll
      for (int i = 0; i < 8; ++i) { const int kk = 8 * i + (lane >> 3); const float g = gk ? gk[(k0 + kk) & kmask] * gscale : 1.0f;
#pragma unroll
          for (int j = 0; j < 4; ++j) scr[kk * 33 + 4 * (lane & 7) + j] = v[i][j] * g; } }
    asm volatile("s_waitcnt lgkmcnt(0)" ::: "memory");
    const int q = (n0 & 255) >> 5; const int n0p = (n0 & ~255) + 32 * (4 * (q & 1) + (q >> 1));
    const int c = lane & 7;
#pragma unroll
    for (int j = 0; j < 4; ++j) { const int n = (lane >> 3) + 8 * j; const LAS float* s = scr + (8 * c) * 33 + n;
        u32x4 o; o.x = cvtpk(s[0 * 33], s[1 * 33]); o.y = cvtpk(s[2 * 33], s[3 * 33]); o.z = cvtpk(s[4 * 33], s[5 * 33]); o.w = cvtpk(s[6 * 33], s[7 * 33]);
        *(u32x4*)(WT + (size_t)(n0p + n) * K + k0 + 8 * c) = o; }
    asm volatile("s_waitcnt lgkmcnt(0)" ::: "memory");
}

__device__ __forceinline__ void prologue(KArgs a, LAS unsigned char* lds, int vcu, int G) {
    const int tid = opaque_tid(), lane = tid & 63, wave = tid >> 6;
    unsigned char* ws = a->ws;
    LAS float* scr = (LAS float*)(lds + wave * 16384);
    const int gw = vcu * 8 + wave, NGW = G * 8;
    constexpr int I_IN = 16 * 208;
    for (int it = gw; it < I_IN; it += NGW) p0_transpose_item(a->in[I_WIN], 1024, NIN, (bf16_t*)(ws + WS_WIN), nullptr, scr, it, lane);
    const f32x4* gm = (const f32x4*)a->in[I_GMIX] + lane;
    bf16_t* XN = (bf16_t*)(ws + WS_XN);
    f32x4 gmv[4];
#pragma unroll
    for (int j = 0; j < 4; ++j) gmv[j] = gm[64 * j];
    for (int row = gw; row < M1; row += NGW) {
        unsigned long long* o8 = (unsigned long long*)(XN + (size_t)row * 1024) + lane;
        if (row >= R1) {
#pragma unroll
            for (int j = 0; j < 4; ++j) o8[64 * j] = 0ull;
            continue; }
        const float* src;
        if (row < RP) { const int b = row / TP, t = row - b * TP; src = (t < NMETA) ? a->in[I_META] + (size_t)t * 1024 : a->in[I_XP] + ((size_t)b * SEQ + (t - NMETA)) * 1024; }
        else src = a->in[I_XS] + (size_t)(row - RP) * 1024;
        const f32x4* xr = (const f32x4*)src + lane;
        f32x4 v[4]; float s = 0.f;
#pragma unroll
        for (int j = 0; j < 4; ++j) { v[j] = __builtin_nontemporal_load(xr + 64 * j); s += (v[j][0] * v[j][0] + v[j][1] * v[j][1]) + (v[j][2] * v[j][2] + v[j][3] * v[j][3]); }
        const float rstd = rsqrtf(wave_sum(s) * (1.0f / 1024.0f) + EPS);
#pragma unroll
        for (int j = 0; j < 4; ++j) { const f32x4 g = gmv[j]; const f32x4 y = v[j] * rstd * g;
            o8[64 * j] = (unsigned long long)cvtpk(y[0], y[1]) | ((unsigned long long)cvtpk(y[2], y[3]) << 32); }
    }
    float* rope = (float*)(ws + WS_ROPE);
    for (int e = vcu * 512 + tid; e < (PAST + DS) * 8; e += G * 512) {
        const int pos = e >> 3, i = e & 7;
        const float inv = (i == 0) ? 1.0f : (i == 1) ? 0.1939227432012558f : (i == 2) ? 0.03760603070259094f : (i == 3) ? 0.007292664609849453f :
                          (i == 4) ? 0.0014142135623842478f : (i == 5) ? 0.00027424818836152554f : (i == 6) ? 5.318296098266728e-05f : 1.0313386155758053e-05f;
        const float ang = (float)pos * inv;
        double rev = (double)ang * 0.15915494309189535; rev -= floor(rev);
        const float rf = (float)rev;
        rope[pos * 16 + i] = __builtin_amdgcn_cosf(rf); rope[pos * 16 + 8 + i] = __builtin_amdgcn_sinf(rf);
    }
}

__device__ __forceinline__ void convert_late_weights(KArgs a, LAS unsigned char* lds, int idx, int n) {
    const int tid = opaque_tid(), lane = tid & 63, wave = tid >> 6;
    unsigned char* ws = a->ws;
    LAS float* scr = (LAS float*)(lds + wave * 16384);
    constexpr int I_DO = 16 * 32, I_SO = 8 * 32, I_OUT = 16 * 32, I_F1 = 16 * 128, I_F2 = 64 * 32;
    constexpr int NITEMS = I_DO + I_SO + I_OUT + I_F1 + I_F2;
    for (int it = idx * 8 + wave; it < NITEMS; it += n * 8) {
        int r = it;
        if (r < I_DO) { p0_transpose_item(a->in[I_WDO], 1024, 1024, (bf16_t*)(ws + WS_WDO), a->in[I_SUBG], scr, r, lane, 127, 1.0f - LAM_INIT); continue; } r -= I_DO;
        if (r < I_SO) { p0_transpose_item(a->in[I_WSO], 512, 1024, (bf16_t*)(ws + WS_WSO), nullptr, scr, r, lane); continue; } r -= I_SO;
        if (r < I_OUT) { p0_transpose_item(a->in[I_WOUT], 1024, 1024, (bf16_t*)(ws + WS_WOUT), nullptr, scr, r, lane); continue; } r -= I_OUT;
        if (r < I_F1) { p0_transpose_item(a->in[I_W1], 1024, DFF, (bf16_t*)(ws + WS_W1), a->in[I_GFFN], scr, r, lane); continue; } r -= I_F1;
        p0_transpose_item(a->in[I_W2], DFF, 1024, (bf16_t*)(ws + WS_W2), nullptr, scr, r, lane);
    }
}

constexpr int ATT_STAGE = 34816, ATT_VOFF = 17408, ATT_WSF = 2 * ATT_STAGE, ATT_QOFF = ATT_WSF + 2048;
#define MFMA32(a, b, c) __builtin_amdgcn_mfma_f32_32x32x16_bf16((a), (b), (c), 0, 0, 0)

__device__ __forceinline__ float rowmax32(const f32x16& p0, const f32x16& p1) {
    float a = fmaxf(p0[0], p1[0]);
#pragma unroll
    for (int r = 1; r < 16; ++r) a = fmaxf(a, fmaxf(p0[r], p1[r]));
    return fmaxf(a, __shfl_xor(a, 32));
}
__device__ __forceinline__ void packP(const f32x16& p0, const f32x16& p1, bf16x8 (&pa)[4]) {
    u32x4 w;
    w = (u32x4){cvtpk(p0[0], p0[1]), cvtpk(p0[2], p0[3]), cvtpk(p0[4], p0[5]), cvtpk(p0[6], p0[7])}; pa[0] = __builtin_bit_cast(bf16x8, w);
    w = (u32x4){cvtpk(p0[8], p0[9]), cvtpk(p0[10], p0[11]), cvtpk(p0[12], p0[13]), cvtpk(p0[14], p0[15])}; pa[1] = __builtin_bit_cast(bf16x8, w);
    w = (u32x4){cvtpk(p1[0], p1[1]), cvtpk(p1[2], p1[3]), cvtpk(p1[4], p1[5]), cvtpk(p1[6], p1[7])}; pa[2] = __builtin_bit_cast(bf16x8, w);
    w = (u32x4){cvtpk(p1[8], p1[9]), cvtpk(p1[10], p1[11]), cvtpk(p1[12], p1[13]), cvtpk(p1[14], p1[15])}; pa[3] = __builtin_bit_cast(bf16x8, w);
}

constexpr int D1_VOFF = 17408, D1_QOFF = 2 * ATT_STAGE + 2048;
__device__ __forceinline__ void diff_unit1(KArgs a, LAS unsigned char* lds, int b, int h, int qb, float lam) {
    const int tid = opaque_tid(), lane = tid & 63, r32 = lane & 31, hi = lane >> 5;
    const int wid = __builtin_amdgcn_readfirstlane(tid >> 6);
    unsigned char* ws = a->ws;
    const int rowb = b * TP;
    const int q0 = NMETA + 256 * qb + 32 * wid;
    const int jmax = 4 * qb + 4, jw = 4 * qb + (wid >> 1) + 1;
    const bf16_t* Kb = (const bf16_t*)(ws + WS_KD) + (size_t)rowb * 1024 + h * 128;
    const bf16_t* Vb = (const bf16_t*)(ws + WS_VD) + (size_t)rowb * 1024 + h * 128;
    LAS unsigned char* qlds = lds + D1_QOFF + wid * 8192 + lane * 16;
    f32x16 o[2][4];
#pragma unroll
    for (int s = 0; s < 2; ++s)
#pragma unroll
        for (int d0 = 0; d0 < 4; ++d0)
#pragma unroll
            for (int r = 0; r < 16; ++r) o[s][d0][r] = 0.f;
    float ls[2] = {0.f, 0.f};
    int never = 0; asm volatile("" : "+s"(never));
    LAS float* wsf = (LAS float*)(lds + ATT_WSF) + wid * 64;
    const int kkv = tid >> 4, kdc = tid & 15;
    const int vkp = tid & 31, vdc = tid >> 5;
    u32x4 kr[2], vr[2];
#define DA_GLOAD(j) do { \
        _Pragma("unroll") for (int i_ = 0; i_ < 2; ++i_) { int pos_ = 64 * (j) - 48 + kkv + 32 * i_; pos_ = pos_ < 0 ? 0 : pos_; kr[i_] = *(const u32x4*)(Kb + (size_t)pos_ * 1024 + kdc * 8); } \
        _Pragma("unroll") for (int i_ = 0; i_ < 2; ++i_) { int pos_ = 64 * (j) - 48 + 2 * vkp + i_; pos_ = pos_ < 0 ? 0 : pos_; vr[i_] = *(const u32x4*)(Vb + (size_t)pos_ * 1024 + vdc * 8); } } while (0)
#define DA_LSTORE(st_) do { LAS unsigned char* sb_ = lds + (st_) * ATT_STAGE; \
        _Pragma("unroll") for (int i_ = 0; i_ < 2; ++i_) *(LAS u32x4*)(sb_ + (kkv + 32 * i_) * 272 + kdc * 16) = kr[i_]; \
        _Pragma("unroll") for (int e_ = 0; e_ < 8; ++e_) { const unsigned lo_ = (vr[0][e_ >> 1] >> (16 * (e_ & 1))) & 0xffffu, hi_ = (vr[1][e_ >> 1] >> (16 * (e_ & 1))) & 0xffffu; \
            *(LAS unsigned*)(sb_ + D1_VOFF + (8 * vdc + e_) * 136 + vkp * 4) = lo_ | (hi_ << 16); } } while (0)
    DA_GLOAD(0);
    { const bf16_t* Qp = (const bf16_t*)(ws + WS_QD) + (size_t)(rowb + q0 + r32) * 1024 + h * 128 + hi * 8;
#pragma unroll
      for (int s = 0; s < 2; ++s)
#pragma unroll
          for (int d0 = 0; d0 < 4; ++d0) *(LAS bf16x8*)(qlds + (s * 4 + d0) * 1024) = *(const bf16x8*)(Qp + s * 64 + d0 * 16); }
    DA_LSTORE(0);
    __syncthreads();
    for (int j = 0; j <= jmax; ++j) {
        if (j < jmax) DA_GLOAD(j + 1);
        if (j <= jw) {
            const LAS unsigned char* Ks = lds + (j & 1) * ATT_STAGE + r32 * 272 + hi * 16;
            const LAS unsigned char* Vs = lds + (j & 1) * ATT_STAGE + D1_VOFF + r32 * 136 + hi * 8;
#pragma unroll
            for (int s = 0; s < 2; ++s) {
#pragma unroll
                for (int hf = 0; hf < 2; ++hf) {
                    if (j == 0 && hf == 0) continue;
                    f32x16 p;
#pragma unroll
                    for (int r = 0; r < 16; ++r) p[r] = 0.f;
#pragma unroll
                    for (int d0 = 0; d0 < 4; ++d0) {
                        const bf16x8 ka = *(const LAS bf16x8*)(Ks + hf * 32 * 272 + s * 128 + d0 * 32);
                        const bf16x8 qf = *(const LAS bf16x8*)(qlds + (s * 4 + d0) * 1024);
                        p = MFMA32(ka, qf, p); }
                    if (j == 0) {
#pragma unroll
                        for (int r = 0; r < 16; ++r) if (crow(r, hi) < 16) p[r] = -INFINITY; }
                    if (never) asm volatile("s_nop 0");
                    float sum = 0.f;
#pragma unroll
                    for (int r = 0; r < 16; ++r) { p[r] = ex2(p[r]); sum += p[r]; }
                    ls[s] += sum;
                    u32x4 w0 = {cvtpk(p[0], p[1]), cvtpk(p[2], p[3]), cvtpk(p[4], p[5]), cvtpk(p[6], p[7])}, w1 = {cvtpk(p[8], p[9]), cvtpk(p[10], p[11]), cvtpk(p[12], p[13]), cvtpk(p[14], p[15])};
                    const bf16x8 pa0 = __builtin_bit_cast(bf16x8, w0), pa1 = __builtin_bit_cast(bf16x8, w1);
                    {
                        const unsigned vb_ = (unsigned)(size_t)(Vs) + hf * 64;
                        const unsigned vb0 = vb_, vb1 = vb_ + 4352, vb2 = vb_ + 2 * 4352, vb3 = vb_ + 3 * 4352;
                        u32x4 fa, fb;
#define VRD(dst_, base_, k_) asm volatile("ds_read2_b64 %0, %1 offset0:%2 offset1:%3" : "=v"(dst_) : "v"(base_), "n"((k_) * 4), "n"((k_) * 4 + 2) : "memory")
#define VWT(n_, dst_) asm volatile("s_waitcnt lgkmcnt(" #n_ ")" : "+v"(dst_) :: "memory")
                        VRD(fa, vb0, 0); VRD(fb, vb0, 1);
                        VWT(1, fa); o[s][0] = MFMA32(pa0, __builtin_bit_cast(bf16x8, fa), o[s][0]); VRD(fa, vb1, 0);
                        VWT(1, fb); o[s][0] = MFMA32(pa1, __builtin_bit_cast(bf16x8, fb), o[s][0]); VRD(fb, vb1, 1);
                        VWT(1, fa); o[s][1] = MFMA32(pa0, __builtin_bit_cast(bf16x8, fa), o[s][1]); VRD(fa, vb2, 0);
                        VWT(1, fb); o[s][1] = MFMA32(pa1, __builtin_bit_cast(bf16x8, fb), o[s][1]); VRD(fb, vb2, 1);
                        VWT(1, fa); o[s][2] = MFMA32(pa0, __builtin_bit_cast(bf16x8, fa), o[s][2]); VRD(fa, vb3, 0);
                        VWT(1, fb); o[s][2] = MFMA32(pa1, __builtin_bit_cast(bf16x8, fb), o[s][2]); VRD(fb, vb3, 1);
                        VWT(1, fa); o[s][3] = MFMA32(pa0, __builtin_bit_cast(bf16x8, fa), o[s][3]);
                        VWT(0, fb); o[s][3] = MFMA32(pa1, __builtin_bit_cast(bf16x8, fb), o[s][3]);
#undef VRD
#undef VWT
                    }
                }
            }
        }
        if (j < jmax) DA_LSTORE((j + 1) & 1);
        __syncthreads();
    }
#undef DA_GLOAD
#undef DA_LSTORE
    ls[0] += __shfl_xor(ls[0], 32); ls[1] += __shfl_xor(ls[1], 32);
    if (hi == 0) { wsf[r32] = 1.0f / ls[0]; wsf[32 + r32] = lam / ls[1]; }
    bf16_t* Od = (bf16_t*)(ws + WS_OD) + (size_t)(b * SEQ + 256 * qb + 32 * wid) * 1024 + h * 128 + r32;
#pragma unroll
    for (int r = 0; r < 16; ++r) {
        const float f1 = wsf[crow(r, hi)], f2 = wsf[32 + crow(r, hi)];
        float v[4]; float ss = 0.f;
#pragma unroll
        for (int d0 = 0; d0 < 4; ++d0) { v[d0] = o[0][d0][r] * f1 - o[1][d0][r] * f2; ss += v[d0] * v[d0]; }
#pragma unroll
        for (int off = 1; off < 32; off <<= 1) ss += __shfl_xor(ss, off);
        const float rstd = rsqrtf(ss * (1.0f / 128.0f) + EPS);
#pragma unroll
        for (int d0 = 0; d0 < 4; ++d0) Od[(size_t)crow(r, hi) * 1024 + 32 * d0] = (bf16_t)(cvtpk(v[d0] * rstd, 0.f) & 0xffffu);
    }
}

__device__ __forceinline__ void sb_weights(f32x16& z0, f32x16& z1, float& R, int hi) {
    f32x16 s0, s1;
#pragma unroll
    for (int r = 0; r < 16; ++r) { z0[r] = ex2(z0[r]); z1[r] = ex2(z1[r]); s0[r] = __builtin_amdgcn_rcpf(1.0f + z0[r]); s1[r] = __builtin_amdgcn_rcpf(1.0f + z1[r]); }
    float gs[8], pg[8], off[8];
#pragma unroll
    for (int g = 0; g < 4; ++g) { gs[g] = (s0[4 * g] * s0[4 * g + 1]) * (s0[4 * g + 2] * s0[4 * g + 3]); gs[4 + g] = (s1[4 * g] * s1[4 * g + 1]) * (s1[4 * g + 2] * s1[4 * g + 3]); }
#pragma unroll
    for (int g = 0; g < 8; ++g) pg[g] = __shfl_xor(gs[g], 32);
    float run = ex2(-R);
#pragma unroll
    for (int g = 7; g >= 0; --g) { off[g] = run * (hi == 0 ? pg[g] : 1.0f); run *= gs[g] * pg[g]; }
    float tp = 1.0f;
#pragma unroll
    for (int g = 0; g < 8; ++g) tp *= gs[g] * pg[g];
    R -= lg2(tp);
#pragma unroll
    for (int g = 0; g < 4; ++g) {
        float c = off[g];
#pragma unroll
        for (int e = 3; e >= 0; --e) { c *= s0[4 * g + e]; z0[4 * g + e] *= c; }
        c = off[4 + g];
#pragma unroll
        for (int e = 3; e >= 0; --e) { c *= s1[4 * g + e]; z1[4 * g + e] *= c; }
    }
}

constexpr int SB_VOFF = 9216;
__device__ __forceinline__ void sb_unit(KArgs a, LAS unsigned char* lds, int b, int h, int qb) {
    const int tid = opaque_tid(), lane = tid & 63, r32 = lane & 31, hi = lane >> 5;
    const int wid = __builtin_amdgcn_readfirstlane(tid >> 6);
    unsigned char* ws = a->ws;
    const int rowb = b * TP;
    const int q0 = NMETA + 256 * qb + 32 * wid;
    const int jmax = 4 * qb + 4, jw = 4 * qb + (wid >> 1) + 1;
    const bf16_t* Kb = (const bf16_t*)(ws + WS_KS) + (size_t)rowb * 512 + h * 64;
    const bf16_t* Vb = (const bf16_t*)(ws + WS_VS) + (size_t)rowb * 512 + h * 64;
    bf16x8 q[4];
    { const bf16_t* Qp = (const bf16_t*)(ws + WS_QS) + (size_t)(rowb + q0 + r32) * 512 + h * 64 + hi * 8;
#pragma unroll
      for (int d0 = 0; d0 < 4; ++d0) q[d0] = *(const bf16x8*)(Qp + d0 * 16); }
    f32x16 o[2];
#pragma unroll
    for (int d0 = 0; d0 < 2; ++d0)
#pragma unroll
        for (int r = 0; r < 16; ++r) o[d0][r] = 0.f;
    float R = 0.f;
    const int kkv = tid >> 3, kdc = tid & 7;
    const int vkp = tid & 31, vdc = (tid >> 5) & 7;
    u32x4 kr, vr[2];
#define SB_GLOAD(j) do { \
        { int pos_ = 64 * (j) - 48 + kkv; pos_ = pos_ < 0 ? 0 : pos_; kr = *(const u32x4*)(Kb + (size_t)pos_ * 512 + kdc * 8); } \
        if (tid < 256) { _Pragma("unroll") for (int i_ = 0; i_ < 2; ++i_) { int pos_ = 64 * (j) - 48 + 2 * vkp + i_; pos_ = pos_ < 0 ? 0 : pos_; vr[i_] = *(const u32x4*)(Vb + (size_t)pos_ * 512 + vdc * 8); } } } while (0)
#define SB_LSTORE(s) do { LAS unsigned char* sb_ = lds + (s) * ATT_STAGE; \
        *(LAS u32x4*)(sb_ + kkv * 144 + kdc * 16) = kr; \
        if (tid < 256) { _Pragma("unroll") for (int e_ = 0; e_ < 8; ++e_) { const unsigned lo_ = (vr[0][e_ >> 1] >> (16 * (e_ & 1))) & 0xffffu, hi_ = (vr[1][e_ >> 1] >> (16 * (e_ & 1))) & 0xffffu; \
            *(LAS unsigned*)(sb_ + SB_VOFF + (8 * vdc + e_) * 136 + vkp * 4) = lo_ | (hi_ << 16); } } } while (0)
    SB_GLOAD(jmax); SB_LSTORE(0);
    __syncthreads();
    int st = 0;
    for (int j = jmax; j >= 0; --j) {
        if (j > 0) SB_GLOAD(j - 1);
        if (j <= jw) {
            const LAS unsigned char* Ks = lds + st * ATT_STAGE + r32 * 144 + hi * 16;
            const LAS unsigned char* Vs = lds + st * ATT_STAGE + SB_VOFF + r32 * 136 + hi * 8;
            f32x16 p0, p1;
#pragma unroll
            for (int r = 0; r < 16; ++r) { p0[r] = 0.f; p1[r] = 0.f; }
#pragma unroll
            for (int d0 = 0; d0 < 4; ++d0) {
                const bf16x8 ka = *(const LAS bf16x8*)(Ks + d0 * 32), kb = *(const LAS bf16x8*)(Ks + 32 * 144 + d0 * 32);
                p0 = MFMA32(ka, q[d0], p0); p1 = MFMA32(kb, q[d0], p1); }
            if (j == jw) { const int qrel = 32 * (wid & 1) + r32; asm volatile("" ::: "memory");
#pragma unroll
                for (int r = 0; r < 16; ++r) { if (crow(r, hi) >= qrel) p0[r] = -INFINITY; if (crow(r, hi) + 32 >= qrel) p1[r] = -INFINITY; } }
            if (j == 0) { asm volatile("" ::: "memory");
#pragma unroll
                for (int r = 0; r < 16; ++r) { p0[r] = -INFINITY; if (crow(r, hi) < 16) p1[r] = -INFINITY; } }
            sb_weights(p0, p1, R, hi);
            bf16x8 pa[4]; packP(p0, p1, pa);
            {
                const unsigned vb0 = (unsigned)(size_t)(Vs), vb1 = vb0 + 4352;
                u32x4 fa, fb;
#define VRD(dst_, base_, k_) asm volatile("ds_read2_b64 %0, %1 offset0:%2 offset1:%3" : "=v"(dst_) : "v"(base_), "n"((k_) * 4), "n"((k_) * 4 + 2) : "memory")
#define VWT(n_, dst_) asm volatile("s_waitcnt lgkmcnt(" #n_ ")" : "+v"(dst_) :: "memory")
                VRD(fa, vb0, 0); VRD(fb, vb0, 1);
                VWT(1, fa); o[0] = MFMA32(pa[0], __builtin_bit_cast(bf16x8, fa), o[0]); VRD(fa, vb0, 2);
                VWT(1, fb); o[0] = MFMA32(pa[1], __builtin_bit_cast(bf16x8, fb), o[0]); VRD(fb, vb0, 3);
                VWT(1, fa); o[0] = MFMA32(pa[2], __builtin_bit_cast(bf16x8, fa), o[0]); VRD(fa, vb1, 0);
                VWT(1, fb); o[0] = MFMA32(pa[3], __builtin_bit_cast(bf16x8, fb), o[0]); VRD(fb, vb1, 1);
                VWT(1, fa); o[1] = MFMA32(pa[0], __builtin_bit_cast(bf16x8, fa), o[1]); VRD(fa, vb1, 2);
                VWT(1, fb); o[1] = MFMA32(pa[1], __builtin_bit_cast(bf16x8, fb), o[1]); VRD(fb, vb1, 3);
                VWT(1, fa); o[1] = MFMA32(pa[2], __builtin_bit_cast(bf16x8, fa), o[1]);
                VWT(0, fb); o[1] = MFMA32(pa[3], __builtin_bit_cast(bf16x8, fb), o[1]);
#undef VRD
#undef VWT
            }
        }
        if (j > 0) SB_LSTORE(st ^ 1);
        __syncthreads();
        st ^= 1;
    }
#undef SB_GLOAD
#undef SB_LSTORE
    LAS bf16_t* stg = (LAS bf16_t*)(lds + wid * 4608);
#pragma unroll
    for (int r = 0; r < 16; ++r)
#pragma unroll
        for (int d0 = 0; d0 < 2; ++d0) stg[crow(r, hi) * 72 + 32 * d0 + r32] = (bf16_t)(cvtpk(o[d0][r], 0.f) & 0xffffu);
    bf16_t* Os = (bf16_t*)(ws + WS_OS) + (size_t)(b * SEQ + 256 * qb + 32 * wid) * 512 + h * 64;
#pragma unroll
    for (int i = 0; i < 4; ++i) { const int row = 8 * i + (lane >> 3), ch = lane & 7;
        *(u32x4*)(Os + (size_t)row * 512 + 8 * ch) = *(const LAS u32x4*)(stg + row * 72 + 8 * ch); }
    __syncthreads();
}

__device__ __forceinline__ bf16x8 ld8f(const float* p) { const f32x4 a = __builtin_nontemporal_load((const f32x4*)p), b = __builtin_nontemporal_load((const f32x4*)(p + 4));
    const u32x4 w = {cvtpk(a[0], a[1]), cvtpk(a[2], a[3]), cvtpk(b[0], b[1]), cvtpk(b[2], b[3])}; return __builtin_bit_cast(bf16x8, w); }

__device__ __forceinline__ void sample_unit(KArgs a, LAS unsigned char* lds, int b, int h, int split) {
    const int tid = opaque_tid(), lane = tid & 63, r32 = lane & 31, hi = lane >> 5;
    const int wid = __builtin_amdgcn_readfirstlane(tid >> 6);
    unsigned char* ws = a->ws;
    const int nt = 2;
    const int kbase = split * 1024 + wid * 128;
    const int srow = RP + b * DS;
    float* part = (float*)(ws + WS_PART) + (size_t)((b * 8 + h) * 4 + split) * PART_FLOATS;
    LAS float* wsf = (LAS float*)(lds + 65536) + wid * 64;
    LAS float* accs = (LAS float*)lds;
    LAS float* stat = (LAS float*)(lds + 32768);
    const unsigned koffL = (unsigned)(r32 * 1024 + hi * 8);
    const unsigned voffL4 = (unsigned)(4 * hi * 1024 + 4 * r32);
    int one_ = 1; asm volatile("" : "+s"(one_));
    for (int it_ = 0; it_ < one_; ++it_) { const int s = wid & 1; const int kb4 = split * 1024 + (wid >> 1) * 256;
        bf16x8 q[4];
        { const bf16_t* Qp = (const bf16_t*)(ws + WS_QD) + (size_t)(srow + r32) * 1024 + h * 128 + s * 64 + hi * 8;
#pragma unroll
          for (int d0 = 0; d0 < 4; ++d0) q[d0] = *(const bf16x8*)(Qp + d0 * 16); }
        f32x16 o[4];
#pragma unroll
        for (int d0 = 0; d0 < 4; ++d0)
#pragma unroll
            for (int r = 0; r < 16; ++r) o[d0][r] = 0.f;
        float mx = -INFINITY, ls = 0.f;
        for (int t = 3; t >= 0; --t) {
            const bool isnew = false;
            const float* kt = (isnew ? a->out + O_SDK + (size_t)(b * DS) * 1024 + h * 128 : a->in[I_CDK] + ((size_t)(b * PAST + kb4 + 64 * t) * 8 + h) * 128) + s * 64;
            const float* vt = isnew ? a->out + O_SDV + (size_t)(b * DS) * 1024 + h * 128 : a->in[I_CDV] + ((size_t)(b * PAST + kb4 + 64 * t) * 8 + h) * 128;
            f32x16 p0, p1;
#pragma unroll
            for (int r = 0; r < 16; ++r) { p0[r] = 0.f; p1[r] = 0.f; }
            { bf16x8 ka[4], kb[4];
#pragma unroll
              for (int d0 = 0; d0 < 4; ++d0) { ka[d0] = ld8f(kt + d0 * 16 + koffL); kb[d0] = ld8f(kt + 32 * 1024 + d0 * 16 + koffL); }
#pragma unroll
              for (int d0 = 0; d0 < 4; ++d0) { p0 = MFMA32(ka[d0], q[d0], p0); p1 = MFMA32(kb[d0], q[d0], p1); } }
            if (isnew) {
#pragma unroll
                for (int r = 0; r < 16; ++r) p1[r] = -INFINITY; }
            const float rm = rowmax32(p0, p1);
            if (__any(rm > mx + 8.0f)) {
                const float mn = fmaxf(mx, rm); const float f = ex2(mx - mn); mx = mn; ls *= f;
                if (hi == 0) wsf[r32] = f;
#pragma unroll
                for (int r = 0; r < 16; ++r) { const float fr_ = wsf[crow(r, hi)];
#pragma unroll
                    for (int d0 = 0; d0 < 4; ++d0) o[d0][r] *= fr_; }
            }
            float sum = 0.f;
#pragma unroll
            for (int r = 0; r < 16; ++r) { p0[r] = ex2(p0[r] - mx); p1[r] = ex2(p1[r] - mx); sum += p0[r] + p1[r]; }
            ls += sum;
            bf16x8 pa[4]; packP(p0, p1, pa);
#pragma unroll
            for (int kp = 0; kp < 2; ++kp) {
                if (isnew && kp == 1) break;
                f32x4 v[2][8];
#pragma unroll
                for (int k2 = 0; k2 < 2; ++k2)
#pragma unroll
                    for (int e = 0; e < 8; ++e) v[k2][e] = __builtin_nontemporal_load((const f32x4*)(vt + (16 * (2 * kp + k2) + (e & 3) + 8 * (e >> 2)) * 1024 + voffL4));
#pragma unroll
                for (int k2 = 0; k2 < 2; ++k2)
#pragma unroll
                    for (int d0 = 0; d0 < 4; ++d0) { float t[8];
#pragma unroll
                        for (int e = 0; e < 8; ++e) t[e] = v[k2][e][d0];
                        const u32x4 vv = pack8(t); o[d0] = MFMA32(pa[2 * kp + k2], __builtin_bit_cast(bf16x8, vv), o[d0]); }
            }
        }
        ls += __shfl_xor(ls, 32);
        if (hi == 0) stat[wid * 32 + r32] = mx;
        __syncthreads();
        float mb = stat[s * 32 + r32];
#pragma unroll
        for (int j = 1; j < 4; ++j) mb = fmaxf(mb, stat[(2 * j + s) * 32 + r32]);
        const float fw = ex2(mx - mb);
        if (hi == 0) wsf[r32] = fw;
        LAS float* lacc = stat + 512;
        for (int w = 0; w < 4; ++w) {
            if ((wid >> 1) == w) {
#pragma unroll
                for (int r = 0; r < 16; ++r) { const int qq = crow(r, hi); const float f = wsf[qq];
#pragma unroll
                    for (int d0 = 0; d0 < 4; ++d0) { LAS float* p = accs + (s * 32 + qq) * 128 + 4 * r32 + d0; const float v = o[d0][r] * f; *p = (w == 0) ? v : *p + v; } }
                if (hi == 0) { LAS float* p = lacc + s * 32 + r32; const float v = ls * fw; *p = (w == 0) ? v : *p + v; }
            }
            __syncthreads();
        }
        if (wid < 2 && hi == 0) { part[s * 64 + r32] = mb; part[s * 64 + 32 + r32] = lacc[s * 32 + r32]; }
    }
    for (int i = tid; i < 2048; i += 512) *(f32x4*)(part + 128 + 4 * i) = *(const LAS f32x4*)(accs + 4 * i);
    __syncthreads();
    {
        bf16x8 q[4];
        { const bf16_t* Qp = (const bf16_t*)(ws + WS_QS) + (size_t)(srow + r32) * 512 + h * 64 + hi * 8;
#pragma unroll
          for (int d0 = 0; d0 < 4; ++d0) q[d0] = *(const bf16x8*)(Qp + d0 * 16); }
        f32x16 o[2];
#pragma unroll
        for (int d0 = 0; d0 < 2; ++d0)
#pragma unroll
            for (int r = 0; r < 16; ++r) o[d0][r] = 0.f;
        float R = 0.f;
        const unsigned koffS = (unsigned)(r32 * 512 + hi * 8), voffS2 = (unsigned)(4 * hi * 512 + 2 * r32);
        for (int t = nt - 1; t >= 0; --t) {
            asm volatile("" ::: "memory");
            const bool isnew = (t == 2);
            const float* kt = isnew ? a->out + O_SSK + (size_t)(b * DS) * 512 + h * 64 : a->in[I_CSK] + ((size_t)(b * PAST + kbase + 64 * t) * 8 + h) * 64;
            const float* vt = isnew ? a->out + O_SSV + (size_t)(b * DS) * 512 + h * 64 : a->in[I_CSV] + ((size_t)(b * PAST + kbase + 64 * t) * 8 + h) * 64;
            f32x16 p0, p1;
#pragma unroll
            for (int r = 0; r < 16; ++r) { p0[r] = 0.f; p1[r] = 0.f; }
            { bf16x8 ka[4], kb[4];
#pragma unroll
              for (int d0 = 0; d0 < 4; ++d0) { ka[d0] = ld8f(kt + d0 * 16 + koffS); kb[d0] = ld8f(kt + 32 * 512 + d0 * 16 + koffS); }
#pragma unroll
              for (int d0 = 0; d0 < 4; ++d0) { p0 = MFMA32(ka[d0], q[d0], p0); p1 = MFMA32(kb[d0], q[d0], p1); } }
            if (isnew) {
#pragma unroll
                for (int r = 0; r < 16; ++r) { p1[r] = -INFINITY; if (crow(r, hi) >= r32) p0[r] = -INFINITY; } }
            sb_weights(p0, p1, R, hi);
            bf16x8 pa[4]; packP(p0, p1, pa);
            {
                f32x2_t v[4][8];
#pragma unroll
                for (int ks = 0; ks < 4; ++ks)
#pragma unroll
                    for (int e = 0; e < 8; ++e) v[ks][e] = (isnew && ks >= 2) ? (f32x2_t){0.f, 0.f} : __builtin_nontemporal_load((const f32x2_t*)(vt + (16 * ks + (e & 3) + 8 * (e >> 2)) * 512 + voffS2));
#pragma unroll
                for (int ks = 0; ks < 4; ++ks)
#pragma unroll
                    for (int d0 = 0; d0 < 2; ++d0) { float t[8];
#pragma unroll
                        for (int e = 0; e < 8; ++e) t[e] = v[ks][e][d0];
                        const u32x4 vv = pack8(t); o[d0] = MFMA32(pa[ks], __builtin_bit_cast(bf16x8, vv), o[d0]); }
            }
        }
        if (hi == 0) stat[wid * 32 + r32] = R;
        __syncthreads();
        float offs = 0.f, tot = 0.f;
#pragma unroll
        for (int w = 0; w < 8; ++w) { const float t_ = stat[w * 32 + r32]; tot += t_; if (w > wid) offs += t_; }
        if (hi == 0) wsf[r32] = ex2(-offs);
        for (int w = 0; w < 8; ++w) {
            if (wid == w) {
#pragma unroll
                for (int r = 0; r < 16; ++r) { const int qq = crow(r, hi); const float f = wsf[qq];
#pragma unroll
                    for (int d0 = 0; d0 < 2; ++d0) { LAS float* p = accs + qq * 64 + 2 * r32 + d0; const float v = o[d0][r] * f; *p = (w == 0) ? v : *p + v; } }
            }
            __syncthreads();
        }
        if (tid < 32) part[8320 + tid] = tot;
        { const int i = tid; *(f32x4*)(part + 8352 + 4 * i) = *(const LAS f32x4*)(accs + 4 * i); }
        __syncthreads();
    }
}

__device__ __forceinline__ void sample_combine(KArgs a, LAS unsigned char* lds, int b, int h, float lam) {
    const int tid = opaque_tid(), lane = tid & 63, r32 = lane & 31, hi = lane >> 5;
    const int wid = __builtin_amdgcn_readfirstlane(tid >> 6);
    unsigned char* ws = a->ws;
    const float* part = (const float*)(ws + WS_PART) + (size_t)((b * 8 + h) * 4) * PART_FLOATS;
    LAS float* np = (LAS float*)lds;
    const int srow = RP + b * DS;
    if (wid == 0) {
#pragma unroll
        for (int s = 0; s < 2; ++s) {
            f32x16 p;
#pragma unroll
            for (int r = 0; r < 16; ++r) p[r] = 0.f;
            { const bf16_t* kp = (const bf16_t*)(ws + WS_KD) + (size_t)(srow + r32) * 1024 + h * 128 + s * 64 + hi * 8;
              const bf16_t* qp = (const bf16_t*)(ws + WS_QD) + (size_t)(srow + r32) * 1024 + h * 128 + s * 64 + hi * 8;
#pragma unroll
              for (int d0 = 0; d0 < 4; ++d0) p = MFMA32(*(const bf16x8*)(kp + d0 * 16), *(const bf16x8*)(qp + d0 * 16), p); }
            float m = fmaxf(p[0], p[1]);
#pragma unroll
            for (int r = 2; r < 16; ++r) m = fmaxf(m, p[r]);
            m = fmaxf(m, __shfl_xor(m, 32));
            float l = 0.f;
#pragma unroll
            for (int r = 0; r < 16; ++r) { p[r] = ex2(p[r] - m); l += p[r]; }
            l += __shfl_xor(l, 32);
            const u32x4 w0 = {cvtpk(p[0], p[1]), cvtpk(p[2], p[3]), cvtpk(p[4], p[5]), cvtpk(p[6], p[7])}, w1 = {cvtpk(p[8], p[9]), cvtpk(p[10], p[11]), cvtpk(p[12], p[13]), cvtpk(p[14], p[15])};
            const bf16_t* vp = (const bf16_t*)(ws + WS_VD) + (size_t)(srow + 4 * hi) * 1024 + h * 128 + r32;
#pragma unroll
            for (int d0 = 0; d0 < 4; ++d0) {
                f32x16 o;
#pragma unroll
                for (int r = 0; r < 16; ++r) o[r] = 0.f;
#pragma unroll
                for (int ks = 0; ks < 2; ++ks) { unsigned w[4];
#pragma unroll
                    for (int e2 = 0; e2 < 4; ++e2) { const int e = 2 * e2;
                        const unsigned lo = vp[(size_t)(16 * ks + (e & 3) + 8 * (e >> 2)) * 1024 + 32 * d0], hi_ = vp[(size_t)(16 * ks + ((e + 1) & 3) + 8 * ((e + 1) >> 2)) * 1024 + 32 * d0]; w[e2] = lo | (hi_ << 16); }
                    const u32x4 vv = {w[0], w[1], w[2], w[3]};
                    o = MFMA32(__builtin_bit_cast(bf16x8, ks ? w1 : w0), __builtin_bit_cast(bf16x8, vv), o); }
#pragma unroll
                for (int r = 0; r < 16; ++r) np[128 + (s * 32 + crow(r, hi)) * 128 + 32 * d0 + r32] = o[r];
            }
            if (hi == 0) { np[s * 64 + r32] = m; np[s * 64 + 32 + r32] = l; }
        }
        {
            f32x16 p0, p1;
#pragma unroll
            for (int r = 0; r < 16; ++r) { p0[r] = 0.f; p1[r] = -INFINITY; }
            { const bf16_t* kp = (const bf16_t*)(ws + WS_KS) + (size_t)(srow + r32) * 512 + h * 64 + hi * 8;
              const bf16_t* qp = (const bf16_t*)(ws + WS_QS) + (size_t)(srow + r32) * 512 + h * 64 + hi * 8;
#pragma unroll
              for (int d0 = 0; d0 < 4; ++d0) p0 = MFMA32(*(const bf16x8*)(kp + d0 * 16), *(const bf16x8*)(qp + d0 * 16), p0); }
#pragma unroll
            for (int r = 0; r < 16; ++r) if (crow(r, hi) >= r32) p0[r] = -INFINITY;
            float R = 0.f;
            sb_weights(p0, p1, R, hi);
            const u32x4 w0 = {cvtpk(p0[0], p0[1]), cvtpk(p0[2], p0[3]), cvtpk(p0[4], p0[5]), cvtpk(p0[6], p0[7])}, w1 = {cvtpk(p0[8], p0[9]), cvtpk(p0[10], p0[11]), cvtpk(p0[12], p0[13]), cvtpk(p0[14], p0[15])};
            const bf16_t* vp = (const bf16_t*)(ws + WS_VS) + (size_t)(srow + 4 * hi) * 512 + h * 64 + r32;
#pragma unroll
            for (int d0 = 0; d0 < 2; ++d0) {
                f32x16 o;
#pragma unroll
                for (int r = 0; r < 16; ++r) o[r] = 0.f;
#pragma unroll
                for (int ks = 0; ks < 2; ++ks) { unsigned w[4];
#pragma unroll
                    for (int e2 = 0; e2 < 4; ++e2) { const int e = 2 * e2;
                        const unsigned lo = vp[(size_t)(16 * ks + (e & 3) + 8 * (e >> 2)) * 512 + 32 * d0], hi_ = vp[(size_t)(16 * ks + ((e + 1) & 3) + 8 * ((e + 1) >> 2)) * 512 + 32 * d0]; w[e2] = lo | (hi_ << 16); }
                    const u32x4 vv = {w[0], w[1], w[2], w[3]};
                    o = MFMA32(__builtin_bit_cast(bf16x8, ks ? w1 : w0), __builtin_bit_cast(bf16x8, vv), o); }
#pragma unroll
                for (int r = 0; r < 16; ++r) np[8352 + crow(r, hi) * 64 + 32 * d0 + r32] = o[r];
            }
            if (hi == 0) np[8320 + r32] = R;
        }
    }
    __syncthreads();
    {
        const int qq = tid >> 4, c = tid & 15;
        float v[2][8];
#pragma unroll
        for (int s = 0; s < 2; ++s) {
            float m[5], l[5], M = -INFINITY;
#pragma unroll
            for (int sp = 0; sp < 4; ++sp) { m[sp] = part[sp * PART_FLOATS + s * 64 + qq]; l[sp] = part[sp * PART_FLOATS + s * 64 + 32 + qq]; M = fmaxf(M, m[sp]); }
            m[4] = np[s * 64 + qq]; l[4] = np[s * 64 + 32 + qq]; M = fmaxf(M, m[4]);
            float L = 0.f;
#pragma unroll
            for (int i = 0; i < 8; ++i) v[s][i] = 0.f;
#pragma unroll
            for (int sp = 0; sp < 5; ++sp) { const float f = ex2(m[sp] - M); L += l[sp] * f;
                f32x4 x0, x1;
                if (sp < 4) { const float* op = part + sp * PART_FLOATS + 128 + (s * 32 + qq) * 128 + 8 * c; x0 = *(const f32x4*)op; x1 = *(const f32x4*)(op + 4); }
                else { const LAS float* op = np + 128 + (s * 32 + qq) * 128 + 8 * c; x0 = *(const LAS f32x4*)op; x1 = *(const LAS f32x4*)(op + 4); }
#pragma unroll
                for (int i = 0; i < 4; ++i) { v[s][i] += x0[i] * f; v[s][4 + i] += x1[i] * f; } }
            const float inv = 1.0f / L;
#pragma unroll
            for (int i = 0; i < 8; ++i) v[s][i] *= inv;
        }
        float y[8]; float ss = 0.f;
#pragma unroll
        for (int i = 0; i < 8; ++i) { y[i] = v[0][i] - lam * v[1][i]; ss += y[i] * y[i]; }
#pragma unroll
        for (int off = 1; off < 16; off <<= 1) ss += __shfl_xor(ss, off);
        const float rstd = rsqrtf(ss * (1.0f / 128.0f) + EPS);
#pragma unroll
        for (int i = 0; i < 8; ++i) y[i] *= rstd;
        *(u32x4*)((bf16_t*)(ws + WS_OD) + (size_t)(RC + b * DS + qq) * 1024 + h * 128 + 8 * c) = pack8(y);
    }
    if (tid < 256) {
        const int qq = tid >> 3, c = tid & 7;
        float y[8];
        { const LAS float* op = np + 8352 + qq * 64 + 8 * c; const f32x4 x0 = *(const LAS f32x4*)op, x1 = *(const LAS f32x4*)(op + 4);
#pragma unroll
          for (int i = 0; i < 4; ++i) { y[i] = x0[i]; y[4 + i] = x1[i]; } }
        float offs = np[8320 + qq];
#pragma unroll
        for (int sp = 3; sp >= 0; --sp) { const float f = ex2(-offs);
            const float* op = part + sp * PART_FLOATS + 8352 + qq * 64 + 8 * c; const f32x4 x0 = *(const f32x4*)op, x1 = *(const f32x4*)(op + 4);
#pragma unroll
            for (int i = 0; i < 4; ++i) { y[i] += x0[i] * f; y[4 + i] += x1[i] * f; }
            offs += part[sp * PART_FLOATS + 8320 + qq]; }
        *(u32x4*)((bf16_t*)(ws + WS_OS) + (size_t)(RC + b * DS + qq) * 512 + h * 64 + 8 * c) = pack8(y);
    }
    __syncthreads();
}

__device__ __forceinline__ int phys_row0(int cb) { const int q = cb & 7; return (cb >> 3) * 256 + 32 * (4 * (q & 1) + (q >> 1)); }
__device__ __forceinline__ void skinny_acc(f32x16& acc, const bf16_t* A, const bf16_t* Bt, int K, int row0, int prow0, int wid, int r32, int hi) {
    const int kw = K >> 3;
    const bf16_t* ap = A + (size_t)(row0 + r32) * K + wid * kw + hi * 8;
    const bf16_t* bp = Bt + (size_t)(prow0 + r32) * K + wid * kw + hi * 8;
#pragma unroll 8
    for (int k = 0; k < kw; k += 16) { const bf16x8 av = *(const bf16x8*)(ap + k), bv = *(const bf16x8*)(bp + k); acc = MFMA32(av, bv, acc); }
}
__device__ __forceinline__ void skinny_acc2(f32x16& acc, f32x16& acc2, const bf16_t* A, const bf16_t* Bt, int K, int row0, int prow0, int prow1, int wid, int r32, int hi) {
    const int kw = K >> 3;
    const bf16_t* ap = A + (size_t)(row0 + r32) * K + wid * kw + hi * 8;
    const bf16_t* bp = Bt + (size_t)(prow0 + r32) * K + wid * kw + hi * 8;
    const bf16_t* bq = Bt + (size_t)(prow1 + r32) * K + wid * kw + hi * 8;
#pragma unroll 8
    for (int k = 0; k < kw; k += 16) { const bf16x8 av = *(const bf16x8*)(ap + k), bv = *(const bf16x8*)(bp + k), bw = *(const bf16x8*)(bq + k); acc = MFMA32(av, bv, acc); acc2 = MFMA32(av, bw, acc2); }
}
__device__ __forceinline__ void skinny_put(LAS float* red, const f32x16& acc, int wid, int r32, int hi) {
#pragma unroll
    for (int r = 0; r < 16; ++r) red[(wid * 32 + crow(r, hi)) * 33 + r32] = acc[r];
}
__device__ __forceinline__ void skinny_get(const LAS float* red, int row, int col, float& s0, float& s1) {
    s0 = 0.f; s1 = 0.f;
#pragma unroll
    for (int w = 0; w < 8; ++w) { s0 += red[(w * 32 + row) * 33 + col]; s1 += red[(w * 32 + row) * 33 + col + 1]; }
}
constexpr size_t WS_SSS = WS_SS + 1280 * 1024;
__device__ __forceinline__ void skinny_phase(KArgs a, LAS unsigned char* lds, int which, int vcu, int G) {
    const int tid = opaque_tid(), lane = tid & 63, r32 = lane & 31, hi = lane >> 5;
    const int wid = __builtin_amdgcn_readfirstlane(tid >> 6);
    unsigned char* ws = a->ws;
    LAS float* red = (LAS float*)lds; LAS float* red2 = (LAS float*)(lds + 34816);
    const int row = tid >> 4, col = 2 * (tid & 15);
    const int nunits = (which == 2) ? 512 : 256;
    for (int u = vcu; u < nunits; u += G) {
        const int rb = u & 7; int cb = (which == 2) ? 2 * (u >> 3) : (u >> 3);
        const int row0 = RC + 32 * rb, prow0 = phys_row0(cb);
        const int grow = row0 + row, srow = grow - RC; int gcol = 32 * cb + col;
        f32x16 acc, acc2;
#pragma unroll
        for (int r = 0; r < 16; ++r) { acc[r] = 0.f; acc2[r] = 0.f; }
        if (which == 0) {
            skinny_acc(acc, (const bf16_t*)(ws + WS_OD), (const bf16_t*)(ws + WS_WDO), 1024, row0, prow0, wid, r32, hi);
            skinny_acc(acc2, (const bf16_t*)(ws + WS_OS), (const bf16_t*)(ws + WS_WSO), 512, row0, prow0, wid, r32, hi);
            skinny_put(red, acc, wid, r32, hi); skinny_put(red2, acc2, wid, r32, hi);
        } else if (which == 1) {
            skinny_acc(acc, (const bf16_t*)(ws + WS_XN), (const bf16_t*)(ws + WS_WOUT), 1024, row0, prow0, wid, r32, hi);
            skinny_put(red, acc, wid, r32, hi);
        } else if (which == 2) {
            skinny_acc2(acc, acc2, (const bf16_t*)(ws + WS_OD), (const bf16_t*)(ws + WS_W1), 1024, row0, prow0, phys_row0(cb + 1), wid, r32, hi);
            skinny_put(red, acc, wid, r32, hi); skinny_put(red2, acc2, wid, r32, hi);
        } else {
            skinny_acc(acc, (const bf16_t*)(ws + WS_H), (const bf16_t*)(ws + WS_W2), 4096, row0, prow0, wid, r32, hi);
            skinny_put(red, acc, wid, r32, hi);
        }
        __syncthreads();
        float s0, s1; skinny_get(red, row, col, s0, s1);
        if (which == 0) {
            float t0, t1; skinny_get(red2, row, col, t0, t1);
            const unsigned gd = *(const unsigned*)((const bf16_t*)(ws + WS_G) + (size_t)grow * 2048 + gcol), gs = *(const unsigned*)((const bf16_t*)(ws + WS_G) + (size_t)grow * 2048 + 1024 + gcol);
            *(unsigned*)((bf16_t*)(ws + WS_XN) + (size_t)grow * 1024 + gcol) = cvtpk(bf_lo(gd) * s0 + bf_lo(gs) * t0, bf_hi(gd) * s1 + bf_hi(gs) * t1);
        } else if (which == 1) {
            const float* xr = a->in[I_XS] + (size_t)srow * 1024 + gcol;
            const float v0 = xr[0] + s0, v1 = xr[1] + s1;
            *(f32x2_t*)((float*)(ws + WS_G) + (size_t)grow * 1024 + gcol) = (f32x2_t){v0, v1};
            *(unsigned*)((bf16_t*)(ws + WS_OD) + (size_t)grow * 1024 + gcol) = cvtpk(v0, v1);
            float ss = v0 * v0 + v1 * v1;
#pragma unroll
            for (int off = 1; off < 16; off <<= 1) ss += __shfl_xor(ss, off);
            if ((tid & 15) == 0) ((float*)(ws + WS_SSS))[srow * 32 + cb] = ss;
        } else if (which == 2) {
            const float* sp = (const float*)(ws + WS_SSS) + srow * 32 + col;
            float ss = sp[0] + sp[1];
#pragma unroll
            for (int off = 1; off < 16; off <<= 1) ss += __shfl_xor(ss, off);
            const float r2 = 1.0f / (ss * (1.0f / 1024.0f) + EPS);
            const float h0 = fmaxf(s0, 0.f), h1 = fmaxf(s1, 0.f);
            *(unsigned*)((bf16_t*)(ws + WS_H) + (size_t)grow * 4096 + gcol) = cvtpk(h0 * h0 * r2, h1 * h1 * r2);
            float t0, t1; skinny_get(red2, row, col, t0, t1);
            const float h2 = fmaxf(t0, 0.f), h3 = fmaxf(t1, 0.f);
            *(unsigned*)((bf16_t*)(ws + WS_H) + (size_t)grow * 4096 + gcol + 32) = cvtpk(h2 * h2 * r2, h3 * h3 * r2);
        } else {
            const float* xr = (const float*)(ws + WS_G) + (size_t)grow * 1024 + gcol;
            *(f32x2_t*)(a->out + O_YS + (size_t)srow * 1024 + gcol) = (f32x2_t){xr[0] + s0, xr[1] + s1};
        }
        __syncthreads();
    }
}

#define XB_TMO      128
#define XB_XCNT(j)  (256  + 64 * (j))
#define XB_XSUB(j)  (1280 + 64 * (j))
#define XB_XGEN(j)  (2304 + 64 * (j))
#define XB_TOP      3328
#define XB_TOPGEN   3392
#define XCD_BAR_WORDS 3456
#define XB_SPIN_CAP (1u << 18)

__device__ __forceinline__ unsigned xb_ld(unsigned* p)              { return __hip_atomic_load(p, __ATOMIC_RELAXED, __HIP_MEMORY_SCOPE_AGENT); }
__device__ __forceinline__ unsigned xb_add(unsigned* p, unsigned v) { return __hip_atomic_fetch_add(p, v, __ATOMIC_RELAXED, __HIP_MEMORY_SCOPE_AGENT); }
__device__ __forceinline__ unsigned xb_xcc_id() { return (unsigned)__builtin_amdgcn_s_getreg((3 << 11) | 20) & 0xFu; }
#define XB_SPIN(cond, bar) do { unsigned _sp = 0; while (cond) { __builtin_amdgcn_s_sleep(1); \
    if ((++_sp & 255u) == 0u) { if (xb_ld(&(bar)[XB_TMO])) break; if (_sp > XB_SPIN_CAP) { atomicAdd(&(bar)[XB_TMO], 1u); break; } } } } while (0)

struct XcdBarrier {
    unsigned* bar; unsigned x;
    volatile LAS unsigned* st;
};

__device__ __forceinline__ XcdBarrier xcd_barrier_post(unsigned* bar, volatile LAS unsigned* st) {
    XcdBarrier b; b.bar = bar; b.x = xb_xcc_id(); b.st = st;
    if (threadIdx.x == 0) (void)xb_add(&bar[XB_XCNT(b.x)], 1u);
    return b;
}
__device__ __forceinline__ void xcd_barrier_complete(unsigned* bar, unsigned x, unsigned& nloc, unsigned& nx) {
    const unsigned G = gridDim.x * gridDim.y * gridDim.z;
    unsigned sum, cnt, mine, sp = 0u;
    for (;;) {
        sum = 0u; cnt = 0u; mine = 0u;
#pragma unroll
        for (unsigned j = 0; j < 16; ++j) { const unsigned c = xb_ld(&bar[XB_XCNT(j)]); sum += c; cnt += (c > 0u) ? 1u : 0u; mine = (j == x) ? c : mine; }
        if (sum == G) break;
        __builtin_amdgcn_s_sleep(1);
        if ((++sp & 255u) == 0u) { if (xb_ld(&bar[XB_TMO])) break; if (sp > XB_SPIN_CAP) { atomicAdd(&bar[XB_TMO], 1u); break; } }
    }
    nloc = mine > 0u ? mine : 1u; nx = cnt > 0u ? cnt : 1u;
}

__device__ __forceinline__ void xcd_barrier(const XcdBarrier& b) {
    asm volatile("s_waitcnt vmcnt(0)" ::: "memory");
    __syncthreads();
    if (threadIdx.x == 0) {
        unsigned* bar = b.bar;
        __builtin_amdgcn_s_waitcnt(0);
        unsigned nloc = b.st[0], nx = b.st[1];
        if (nloc == 0u) { xcd_barrier_complete(bar, b.x, nloc, nx); b.st[0] = nloc; b.st[1] = nx; }
        const unsigned old = xb_add(&bar[XB_XSUB(b.x)], 1u);
        const unsigned gen = old / nloc;
        if (old + 1u == (gen + 1u) * nloc) {
            __builtin_amdgcn_fence(__ATOMIC_RELEASE, "agent");
            asm volatile("s_waitcnt vmcnt(0)" ::: "memory");
            const unsigned og = xb_add(&bar[XB_TOP], 1u);
            const unsigned tg = og / nx;
            if (og + 1u == (tg + 1u) * nx) xb_add(&bar[XB_TOPGEN], 1u);
            else XB_SPIN(xb_ld(&bar[XB_TOPGEN]) == tg, bar);
            __builtin_amdgcn_fence(__ATOMIC_ACQUIRE, "agent");
            xb_add(&bar[XB_XGEN(b.x)], 1u);
            asm volatile("s_waitcnt vmcnt(0)" ::: "memory");
        } else {
            XB_SPIN(xb_ld(&bar[XB_XGEN(b.x)]) == gen, bar);
            __builtin_amdgcn_fence(__ATOMIC_ACQUIRE, "agent");
            asm volatile("s_waitcnt vmcnt(0)" ::: "memory");
        }
    }
    __syncthreads();
}

__global__ void __launch_bounds__(512, 2) mega_fwd(Args a_) {
    extern __shared__ __attribute__((aligned(16))) unsigned char lds_raw[];
    LAS unsigned char* lds = (LAS unsigned char*)lds_raw;
    cg::grid_group grid = cg::this_grid();
    const int G = gridDim.x, bx = blockIdx.x;
    const int vcu = (G % 8 == 0) ? (bx % 8) * (G / 8) + bx / 8 : bx;
    KArgs a = (KArgs)__builtin_amdgcn_kernarg_segment_ptr();
#define RELOAD_ARGS() asm volatile("" : "+s"(a))
    unsigned char* ws;

    volatile LAS unsigned* bst = (volatile LAS unsigned*)(lds + LDS_BYTES - 64);
    if (threadIdx.x < 2) bst[threadIdx.x] = 0u;
    RELOAD_ARGS();
    __syncthreads();
    { int never = 0; asm volatile("" : "+s"(never)); if (never) grid.sync(); }
    RELOAD_ARGS();
    (void)xcd_barrier_post((unsigned*)(a->ws + WS_BAR), bst);
#define SEAM() do { RELOAD_ARGS(); XcdBarrier xb_; xb_.bar = (unsigned*)(a->ws + WS_BAR); xb_.x = xb_xcc_id(); xb_.st = bst; xcd_barrier(xb_); } while (0)
    RELOAD_ARGS();
    for (int rep_ = 0; rep_ < REP_P0; ++rep_) prologue(a, lds, vcu, G);
    SEAM();

    for (int rep_ = 0; rep_ < REP_SYNC; ++rep_) SEAM();
    RELOAD_ARGS(); ws = a->ws;
    for (int rep_ = 0; rep_ < REP_P1; ++rep_)
    {
        pg8::Gemm g{(const bf16_t*)(ws + WS_XN), (const bf16_t*)(ws + WS_WIN), M1, NIN, 1024}; pg8::StaticOrder S; S.init(M1, NIN, G, bx);
        EpiIn E{a->out, ws, a->in[I_QG], a->in[I_KG]};
        pg8::gemm_phase<EpiIn, pg8::StaticOrder, true, true>(lds, g, S, E);
    }
    { constexpr int NU = (M1 / 256) * (NIN / 256); const int full = NU / G, first_idle = NU - full * G;
      if (first_idle > 0 && first_idle < G) { if (bx >= first_idle) { RELOAD_ARGS(); convert_late_weights(a, lds, bx - first_idle, G - first_idle); } }
      else { RELOAD_ARGS(); convert_late_weights(a, lds, bx, G); } }
    SEAM();


    RELOAD_ARGS(); ws = a->ws;
    for (int rep_ = 0; rep_ < REP_P2A; ++rep_)
    for (int u = vcu; u < DB * 8 * 4; u += G) { int uu = u; asm volatile("" : "+s"(uu)); RELOAD_ARGS(); sample_unit(a, lds, uu >> 5, (uu >> 2) & 7, uu & 3); }
    SEAM();

    RELOAD_ARGS(); ws = a->ws;
    float lam;
    { const int lane = opaque_tid() & 63;
      const float s1 = wave_sum(a->in[I_LQ1][lane] * a->in[I_LK1][lane]), s2 = wave_sum(a->in[I_LQ2][lane] * a->in[I_LK2][lane]);
      lam = __builtin_bit_cast(float, __builtin_amdgcn_readfirstlane(__builtin_bit_cast(int, __expf(s1) - __expf(s2) + LAM_INIT))); }
    for (int u = vcu; u < DB * 8; u += G) sample_combine(a, lds, u >> 3, u & 7, lam);
    for (int rep_ = 0; rep_ < REP_P2B; ++rep_)
    for (int u = vcu; u < NBATCH * 8 * 8; u += G) {
        const int bh = u >> 3, s = u & 7, b = bh >> 3, h = bh & 7;
        for (int k = 0; k < 2 * REP_DIFF; ++k) { int qb = (k & 1) ? 15 - s : s, bb = b, hh = h; asm volatile("" : "+s"(qb), "+s"(bb), "+s"(hh)); RELOAD_ARGS(); diff_unit1(a, lds, bb, hh, qb, lam); }
        for (int k = 0; k < 2 * REP_SB; ++k) { int qb = (k & 1) ? 15 - s : s, bb = b, hh = h; asm volatile("" : "+s"(qb), "+s"(bb), "+s"(hh)); RELOAD_ARGS(); sb_unit(a, lds, bb, hh, qb); }
    }
    SEAM();

    for (int rep3_ = 0; rep3_ < REP_P3; ++rep3_) {
    RELOAD_ARGS(); ws = a->ws;
    {
        pg8::Gemm g{(const bf16_t*)(ws + WS_OD), (const bf16_t*)(ws + WS_WDO), RC, 1024, 1024}; pg8::StaticOrder S; S.init(RC, 1024, G, bx);
        EpiGateA E{(const bf16_t*)(ws + WS_G), (float*)(ws + WS_T1)};
        pg8::gemm_phase<EpiGateA, pg8::StaticOrder, true, true>(lds, g, S, E);
    }
    __syncthreads();
    RELOAD_ARGS(); ws = a->ws;
    {
        pg8::Gemm g{(const bf16_t*)(ws + WS_OS), (const bf16_t*)(ws + WS_WSO), RC, 1024, 512}; pg8::StaticOrder S; S.init(RC, 1024, G, bx);
        EpiGateB E{(const bf16_t*)(ws + WS_G), (const float*)(ws + WS_T1), (bf16_t*)(ws + WS_XN)};
        pg8::gemm_phase<EpiGateB, pg8::StaticOrder, true, true>(lds, g, S, E);
    }
    RELOAD_ARGS(); skinny_phase(a, lds, 0, vcu, G);
    __syncthreads();
    }
    SEAM();

    RELOAD_ARGS(); ws = a->ws;
    for (int rep_ = 0; rep_ < REP_P4; ++rep_)
    {
        pg8::Gemm g{(const bf16_t*)(ws + WS_XN), (const bf16_t*)(ws + WS_WOUT), RC, 1024, 1024}; pg8::StaticOrder S; S.init(RC, 1024, G, bx);
        EpiOut E{a->in[I_XP], a->in[I_XS], (float*)(ws + WS_G), (bf16_t*)(ws + WS_OD), (float*)(ws + WS_SS)};
        pg8::gemm_phase<EpiOut, pg8::StaticOrder, true, true>(lds, g, S, E);
    }
    RELOAD_ARGS(); skinny_phase(a, lds, 1, vcu, G);
    SEAM();

    RELOAD_ARGS(); ws = a->ws;
    for (int rep_ = 0; rep_ < REP_P5; ++rep_)
    {
        pg8::Gemm g{(const bf16_t*)(ws + WS_OD), (const bf16_t*)(ws + WS_W1), RC, DFF, 1024}; pg8::StaticOrder S; S.init(RC, DFF, G, bx);
        EpiFF1 E{(const float*)(ws + WS_SS), (bf16_t*)(ws + WS_H)};
        pg8::gemm_phase<EpiFF1, pg8::StaticOrder, true, true>(lds, g, S, E);
    }
    RELOAD_ARGS(); skinny_phase(a, lds, 2, vcu, G);
    SEAM();

    RELOAD_ARGS(); ws = a->ws;
    for (int rep_ = 0; rep_ < REP_P6; ++rep_)
    {
        pg8::Gemm g{(const bf16_t*)(ws + WS_H), (const bf16_t*)(ws + WS_W2), RC, 1024, DFF}; pg8::StaticOrder S; S.init(RC, 1024, G, bx);
        EpiFF2 E{(const float*)(ws + WS_G), a->out};
        pg8::gemm_phase<EpiFF2, pg8::StaticOrder, true, true>(lds, g, S, E);
    }
    RELOAD_ARGS(); skinny_phase(a, lds, 3, vcu, G);
}

extern "C" void kernel_launch(void* const* d_in, const int* in_sizes, int n_in, void* d_out, int out_size, void* d_ws, size_t ws_size, hipStream_t stream) {
    static int grid = 0;
    if (grid == 0) {
        if (n_in != 22 || ws_size < WS_END) { fprintf(stderr, "kernel_launch: unexpected n_in %d / ws %zu\n", n_in, ws_size); grid = -1; return; }
        int dev = 0, cus = 0, per_cu = 0;
        hipGetDevice(&dev);
        hipDeviceGetAttribute(&cus, hipDeviceAttributeMultiprocessorCount, dev);
        hipFuncSetAttribute((const void*)mega_fwd, hipFuncAttributeMaxDynamicSharedMemorySize, LDS_BYTES);
        hipOccupancyMaxActiveBlocksPerMultiprocessor(&per_cu, (const void*)mega_fwd, 512, LDS_BYTES);
        if (per_cu < 1) { fprintf(stderr, "kernel_launch: occupancy query says %d blocks/CU\n", per_cu); per_cu = 1; }
        (void)hipGetLastError();
        grid = cus * 1;
    }
    if (grid < 0) return;
    Args a{};
    for (int i = 0; i < 22; ++i) a.in[i] = (const float*)d_in[i];
    a.out = (float*)d_out; a.ws = (unsigned char*)d_ws;
    if (hipMemsetAsync((unsigned char*)d_ws + WS_BAR, 0, XCD_BAR_WORDS * 4, stream) != hipSuccess) { fprintf(stderr, "kernel_launch: hipMemsetAsync failed\n"); return; }
    void* args[] = {&a};
    hipError_t e = hipLaunchCooperativeKernel((const void*)mega_fwd, dim3(grid), dim3(512), args, LDS_BYTES, stream);
    if (e != hipSuccess) fprintf(stderr, "cooperative launch failed: %s (grid %d)\n", hipGetErrorString(e), grid);
}
```
